# Optimizing an MI355X kernel written in HIP

```python
import math
import jax, jax.numpy as jnp
from jax import lax
import numpy as np

D_MODEL = 1024
BATCH = 2
SEQ = 16384
DEPTH = 2

LRU_WIDTH = D_MODEL
LRU_BLOCKS = 8
LRU_BLOCK = LRU_WIDTH // LRU_BLOCKS
CONV_WIDTH = 4
LRU_C = 8.0
POOL_WIDTH = D_MODEL
POOL_WINDOWS = (2, 4, 8, 16)
POOL_GROUPS = len(POOL_WINDOWS)
POOL_GROUP = POOL_WIDTH // POOL_GROUPS
ATT_HEADS = 8
ATT_HEAD_DIM = 64
ATT_V_DIM = 2 * ATT_HEAD_DIM
QK_WIDTH = ATT_HEADS * 2 * ATT_HEAD_DIM
ATT_WIDTH = ATT_HEADS * ATT_V_DIM
ROPE_THETA = 10000.0
Q_BLOCK = 128
N_BRANCH = 3
BRANCH_WIDTH = D_MODEL
IN_SIZES = (LRU_WIDTH, LRU_WIDTH, POOL_WIDTH, QK_WIDTH, QK_WIDTH, ATT_WIDTH, N_BRANCH * D_MODEL)
IN_WIDTH = sum(IN_SIZES)
N_EXPERTS = 16
N_GROUPS = 4
EXPERTS_PER_GROUP = N_EXPERTS // N_GROUPS
TOP_K = 2
D_EXPERT = 512
MOE_CHUNK = 2048
EPS = 1e-6

kernel_name = "hybrid_lru_pool_diffattn_groupmoe_adaln"


def rms_norm(x, g):
    xf = x.astype(jnp.float32)
    y = xf * lax.rsqrt(jnp.mean(xf * xf, axis=-1, keepdims=True) + EPS)
    return (y * g.astype(jnp.float32)).astype(x.dtype)


def split_points():
    pts, acc = [], 0
    for s in IN_SIZES[:-1]:
        acc += s
        pts.append(acc)
    return pts


def rope_tables(seq):
    pos = jnp.arange(seq, dtype=jnp.float32)
    inv = ROPE_THETA ** (-jnp.arange(0, ATT_HEAD_DIM, 2, dtype=jnp.float32) / ATT_HEAD_DIM)
    ang = pos[:, None] * inv[None, :]
    return jnp.cos(ang), jnp.sin(ang)


def apply_rope(x, cos, sin):
    x1, x2 = jnp.split(x, 2, axis=-1)
    c = cos[None, :, None, None, :]
    s = sin[None, :, None, None, :]
    return jnp.concatenate([x1 * c - x2 * s, x2 * c + x1 * s], axis=-1).astype(x.dtype)


def rg_lru_branch(xb, yb, conv_w, conv_b, wa, ba, wx, bx, lru_l):
    B, S, W = xb.shape
    xp = jnp.pad(xb, ((0, 0), (CONV_WIDTH - 1, 0), (0, 0)))
    xc = conv_b
    for j in range(CONV_WIDTH):
        xc = xc + xp[:, j:j + S] * conv_w[j]
    xr = xc.reshape(B, S, LRU_BLOCKS, LRU_BLOCK)
    gate_a = jax.nn.sigmoid(jnp.einsum('bsnc,ncd->bsnd', xr, wa) + ba).reshape(B, S, W)
    gate_x = jax.nn.sigmoid(jnp.einsum('bsnc,ncd->bsnd', xr, wx) + bx).reshape(B, S, W)
    log_a = LRU_C * gate_a.astype(jnp.float32) * jax.nn.log_sigmoid(lru_l.astype(jnp.float32))
    a = jnp.exp(log_a)
    u = jnp.sqrt(-jnp.expm1(2.0 * log_a)) * (gate_x * xc).astype(jnp.float32)

    def combine(left, right):
        a1, b1 = left
        a2, b2 = right
        return a1 * a2, a2 * b1 + b2

    _, h = lax.associative_scan(combine, (a, u), axis=1)
    return h.astype(xb.dtype) * jax.nn.gelu(yb)


def pool_branch(xp, pool_w, pool_scale):
    B, S, W = xp.shape
    xg = xp.reshape(B, S, POOL_GROUPS, POOL_GROUP).astype(jnp.float32)
    cs = jnp.pad(jnp.cumsum(xg, axis=1), ((0, 0), (1, 0), (0, 0), (0, 0)))
    t = jnp.arange(S)
    outs = []
    for g, w in enumerate(POOL_WINDOWS):
        win_sum = cs[:, 1:, g] - jnp.pad(cs[:, :S + 1 - w, g], ((0, 0), (w - 1, 0), (0, 0)))
        cnt = jnp.minimum(t + 1, w).astype(jnp.float32)[None, :, None]
        outs.append(win_sum / cnt - xg[:, :, g])
    pooled = jnp.stack(outs, axis=2).astype(xp.dtype)
    y = jnp.einsum('bsgc,gcd->bsgd', pooled, pool_w).reshape(B, S, W)
    return y * pool_scale


def diff_attention(q, k, v, qn_g, kn_g, lq1, lk1, lq2, lk2, subln_g, lam_init, cos, sin):
    B, S, _ = q.shape
    q = q.reshape(B, S, ATT_HEADS, 2, ATT_HEAD_DIM)
    k = k.reshape(B, S, ATT_HEADS, 2, ATT_HEAD_DIM)
    v = v.reshape(B, S, ATT_HEADS, ATT_V_DIM)
    q = apply_rope(rms_norm(q, qn_g), cos, sin)
    k = apply_rope(rms_norm(k, kn_g), cos, sin)
    lam = (jnp.exp(jnp.sum(lq1.astype(jnp.float32) * lk1.astype(jnp.float32)))
           - jnp.exp(jnp.sum(lq2.astype(jnp.float32) * lk2.astype(jnp.float32))) + lam_init)
    n_blk = S // Q_BLOCK
    qb = q.reshape(B, n_blk, Q_BLOCK, ATT_HEADS, 2, ATT_HEAD_DIM).transpose(1, 0, 3, 4, 2, 5)
    kt = k.transpose(0, 2, 3, 1, 4)
    vt = v.transpose(0, 2, 1, 3)
    starts = jnp.arange(n_blk, dtype=jnp.int32) * Q_BLOCK
    kpos = jnp.arange(S, dtype=jnp.int32)
    scale = ATT_HEAD_DIM ** -0.5

    def block(args):
        q_blk, start = args
        s = jnp.einsum('bhcqd,bhckd->bhcqk', q_blk, kt, preferred_element_type=jnp.float32) * scale
        qpos = start + jnp.arange(Q_BLOCK, dtype=jnp.int32)
        mask = kpos[None, :] <= qpos[:, None]
        p = jax.nn.softmax(jnp.where(mask, s, -jnp.inf), axis=-1)
        attn = p[:, :, 0] - lam * p[:, :, 1]
        return jnp.einsum('bhqk,bhkv->bhqv', attn.astype(vt.dtype), vt)

    o = lax.map(block, (qb, starts))
    o = o.transpose(1, 0, 3, 2, 4).reshape(B, S, ATT_HEADS, ATT_V_DIM)
    o = rms_norm(o, subln_g) * (1.0 - lam_init)
    return o.reshape(B, S, ATT_WIDTH)


def group_moe(h, router_w, router_b, w_gate, w_up, w_down):
    B, S, D = h.shape
    hf = h.reshape(-1, D)
    N = hf.shape[0]
    aff = jax.nn.sigmoid(jnp.matmul(hf, router_w, preferred_element_type=jnp.float32))
    sel = (aff + router_b.astype(jnp.float32)).reshape(N, N_GROUPS, EXPERTS_PER_GROUP)
    gscore = lax.top_k(sel, TOP_K)[0].sum(-1)
    gidx = jnp.argmax(gscore, axis=-1)
    in_group = sel[jnp.arange(N), gidx]
    _, local = lax.top_k(in_group, TOP_K)
    expert = gidx[:, None] * EXPERTS_PER_GROUP + local
    wts = jnp.take_along_axis(aff, expert, axis=1)
    wts = wts / jnp.sum(wts, axis=-1, keepdims=True)
    comb = jnp.zeros((N, N_EXPERTS), jnp.float32).at[jnp.arange(N)[:, None], expert].set(wts)
    pad = (-N) % MOE_CHUNK
    hp = jnp.pad(hf, ((0, pad), (0, 0)))
    cp = jnp.pad(comb, ((0, pad), (0, 0)))
    n_chunk = (N + pad) // MOE_CHUNK

    def chunk(args):
        xt, ct = args
        g = jnp.einsum('td,edf->tef', xt, w_gate)
        u = jnp.einsum('td,edf->tef', xt, w_up)
        act = jax.nn.silu(g) * u * ct[:, :, None].astype(xt.dtype)
        return jnp.einsum('tef,efd->td', act, w_down)

    y = lax.map(chunk, (hp.reshape(n_chunk, MOE_CHUNK, D), cp.reshape(n_chunk, MOE_CHUNK, N_EXPERTS)))
    return y.reshape(-1, D)[:N].reshape(B, S, D)


def setup_inputs(seed: int = 0) -> dict:
    key = jax.random.key(seed)
    ks = jax.random.split(key, 32)
    L, D, E, F = DEPTH, D_MODEL, N_EXPERTS, D_EXPERT

    def nrm(k, shape, scale):
        return jax.random.normal(k, shape, jnp.float32) * scale

    def gain(k, shape):
        return 1.0 + 0.02 * jax.random.normal(k, shape, jnp.float32)

    u = jax.random.uniform(ks[10], (L, LRU_WIDTH), jnp.float32, 0.9, 0.999)
    s = u ** (1.0 / LRU_C)
    lru_l = jnp.log(s) - jnp.log1p(-s)
    return {
        "x": nrm(ks[0], (BATCH, SEQ, D), 1.0),
        "c": nrm(ks[1], (BATCH, D), 1.0),
        "w_ada": nrm(ks[2], (L, D, 6 * D), 0.5 * D ** -0.5),
        "b_ada": nrm(ks[3], (L, 6 * D), 0.01),
        "norm1_g": gain(ks[4], (L, D)),
        "norm2_g": gain(ks[5], (L, D)),
        "w_in": nrm(ks[6], (L, D, IN_WIDTH), D ** -0.5),
        "conv_w": nrm(ks[7], (L, CONV_WIDTH, LRU_WIDTH), CONV_WIDTH ** -0.5),
        "conv_b": nrm(ks[8], (L, LRU_WIDTH), 0.01),
        "lru_wa": nrm(ks[9], (L, LRU_BLOCKS, LRU_BLOCK, LRU_BLOCK), LRU_BLOCK ** -0.5),
        "lru_ba": nrm(ks[11], (L, LRU_BLOCKS, LRU_BLOCK), 0.01),
        "lru_wx": nrm(ks[12], (L, LRU_BLOCKS, LRU_BLOCK, LRU_BLOCK), LRU_BLOCK ** -0.5),
        "lru_bx": nrm(ks[13], (L, LRU_BLOCKS, LRU_BLOCK), 0.01),
        "lru_l": lru_l,
        "pool_w": nrm(ks[14], (L, POOL_GROUPS, POOL_GROUP, POOL_GROUP), POOL_GROUP ** -0.5),
        "pool_scale": gain(ks[15], (L, POOL_WIDTH)),
        "qn_g": gain(ks[16], (L, ATT_HEAD_DIM)),
        "kn_g": gain(ks[17], (L, ATT_HEAD_DIM)),
        "lam_q1": nrm(ks[18], (L, ATT_HEAD_DIM), 0.1),
        "lam_k1": nrm(ks[19], (L, ATT_HEAD_DIM), 0.1),
        "lam_q2": nrm(ks[20], (L, ATT_HEAD_DIM), 0.1),
        "lam_k2": nrm(ks[21], (L, ATT_HEAD_DIM), 0.1),
        "subln_g": gain(ks[22], (L, ATT_V_DIM)),
        "w_branch": nrm(ks[23], (L, N_BRANCH, BRANCH_WIDTH, D), BRANCH_WIDTH ** -0.5),
        "w_out": nrm(ks[24], (L, D, D), D ** -0.5),
        "router_w": nrm(ks[25], (D, E), D ** -0.5),
        "router_b": nrm(ks[26], (E,), 0.01),
        "w_gate": nrm(ks[27], (L, E, D, F), D ** -0.5),
        "w_up": nrm(ks[28], (L, E, D, F), D ** -0.5),
        "w_down": nrm(ks[29], (L, E, F, D), F ** -0.5),
    }


def reference(x, c, w_ada, b_ada, norm1_g, norm2_g, w_in, conv_w, conv_b, lru_wa, lru_ba,
              lru_wx, lru_bx, lru_l, pool_w, pool_scale, qn_g, kn_g, lam_q1, lam_k1, lam_q2,
              lam_k2, subln_g, w_branch, w_out, router_w, router_b, w_gate, w_up, w_down):
    B, S, D = x.shape
    cos, sin = rope_tables(S)
    pts = split_points()
    c_act = jax.nn.silu(c)
    for l in range(DEPTH):
        lam_init = 0.8 - 0.6 * math.exp(-0.3 * l)
        mod = jnp.matmul(c_act, w_ada[l]) + b_ada[l]
        sh1, sc1, g1, sh2, sc2, g2 = jnp.split(mod[:, None, :], 6, axis=-1)
        h = rms_norm(x, norm1_g[l]) * (1.0 + sc1) + sh1
        proj = jnp.matmul(h, w_in[l])
        x_lru, y_lru, x_pool, q, k, v, gates = jnp.split(proj, pts, axis=-1)
        br_lru = rg_lru_branch(x_lru, y_lru, conv_w[l], conv_b[l], lru_wa[l], lru_ba[l],
                               lru_wx[l], lru_bx[l], lru_l[l])
        br_pool = pool_branch(x_pool, pool_w[l], pool_scale[l])
        br_att = diff_attention(q, k, v, qn_g[l], kn_g[l], lam_q1[l], lam_k1[l], lam_q2[l],
                                lam_k2[l], subln_g[l], lam_init, cos, sin)
        gates = jax.nn.sigmoid(gates).reshape(B, S, N_BRANCH, D)
        merged = (gates[:, :, 0] * jnp.matmul(br_lru, w_branch[l, 0])
                  + gates[:, :, 1] * jnp.matmul(br_pool, w_branch[l, 1])
                  + gates[:, :, 2] * jnp.matmul(br_att, w_branch[l, 2]))
        x = x + g1 * jnp.matmul(merged, w_out[l])
        h2 = rms_norm(x, norm2_g[l]) * (1.0 + sc2) + sh2
        x = x + g2 * group_moe(h2, router_w, router_b, w_gate[l], w_up[l], w_down[l])
    return x
```

```cpp
#include <hip/hip_runtime.h>
#include <hip/hip_bf16.h>
#include <cstdio>
#include <cstdint>
#include <cmath>

namespace pg8 {
#define PG8_LAS __attribute__((address_space(3)))
typedef unsigned short bf16_t;
typedef short bf16x8 __attribute__((ext_vector_type(8)));
typedef float f32x4 __attribute__((ext_vector_type(4)));
typedef float f32x2 __attribute__((ext_vector_type(2)));
typedef unsigned u32x4 __attribute__((ext_vector_type(4)));
typedef int i32x4 __attribute__((ext_vector_type(4)));
constexpr int BM = 256, BK = 64, HALF = 128, HTB = HALF * BK * 2  , STAGE_BYTES = 8 * HTB, NXCD = 8, WGM = 8;

__host__ __device__ __forceinline__ int lds_byte(int r, int c) { const int st = (r >> 4) * 2 + (c >> 5), rr = r & 15, cc = c & 31, ob = rr * 64 + cc * 2; return st * 1024 + (ob ^ (((ob >> 9) & 1) << 5)); }
__host__ __device__ __forceinline__ void stage_rc(int b, int& R, int& C) { const int st = b / 1024, sb = b % 1024, swz = sb ^ (((sb >> 9) & 1) << 5); R = (st >> 1) * 16 + swz / 64; C = (st & 1) * 32 + (swz % 64) / 2; }
__host__ __device__ __forceinline__ int perm32(int rho) { const int n = rho >> 4, i = rho & 15; return 8 * (i >> 2) + 4 * n + (i & 3); }

struct GUnit { const char* A; const char* B; int pm, pn, aux, aux2; unsigned va0[2], va1[2]; };

__device__ __forceinline__ bool static_tile(int i, int G, int c, int nM, int nN, int& pm, int& pn) {
    const int nwg = nM * nN; const long L = (long)i * G + c; if (L >= nwg) return false;
    int wgid = (int)L; { const int q = nwg / NXCD, r = nwg % NXCD, xcd = wgid % NXCD, off = wgid / NXCD; wgid = (xcd < r ? xcd * (q + 1) : r * (q + 1) + (xcd - r) * q) + off; }
    const int nig = WGM * nN, gid = wgid / nig, fm = gid * WGM, gsz = (nM - fm) < WGM ? (nM - fm) : WGM;
    pm = fm + ((wgid % nig) % gsz); pn = (wgid % nig) / gsz; return true;
}

__device__ __forceinline__ unsigned cvt_pk_bf16(float lo, float hi) { unsigned r; asm volatile("v_cvt_pk_bf16_f32 %0, %1, %2" : "=v"(r) : "v"(lo), "v"(hi)); return r; }

template <class Epi, class Sched, bool ALIGN_EPI = true, bool SP2 = true>
__device__ __forceinline__ void gemm_phase(PG8_LAS unsigned char* lds, const int tid, const int K, const int lda, const int ldb, const Sched& S, const Epi& E) {
    const int wid = __builtin_amdgcn_readfirstlane(tid >> 6), lane = tid & 63, wr = wid >> 2, wc = wid & 3, fr_k = lane & 15, fq_k = lane >> 4;
    static_assert(SP2 && ALIGN_EPI, "this build keeps only the two-super-phase loop with aligned epilogues");
    const int nt = K / BK;
    constexpr bool PRE = SP2 && ALIGN_EPI && Epi::NSTORE > 0;
    unsigned voffA, voffB;
    { int R, C; stage_rc(tid * 16, R, C); const int Rb = Epi::PERM ? ((R & ~31) + perm32(R & 31)) : R; voffA = (unsigned)(R * lda + C) * 2u; voffB = (unsigned)(Rb * ldb + C) * 2u; }
    const size_t pstepA = (size_t)64 * lda * 2, pstepB = (size_t)64 * ldb * 2;
    const size_t kstep = (size_t)(BK * 2);
    const size_t hstepA = (size_t)HALF * lda * 2, hstepB = (size_t)HALF * ldb * 2;
    const unsigned ldsw = (unsigned)wid * 1024u;
    const int aoff = lds_byte(wr * 64 + fr_k, fq_k * 8), boff = lds_byte(wc * 32 + fr_k, fq_k * 8);
#define PG8_SA(b, h) (((b) * 2 + (h)) * HTB)
#define PG8_SB(b, h) ((4 + (b) * 2 + (h)) * HTB)
#define PG8_STAGE2(bufoff, gbase, voff) do { _Pragma("unroll") for (int _i = 0; _i < 2; ++_i) \
        __builtin_amdgcn_global_load_lds((const unsigned*)((const char*)(gbase) + (voff)[_i]), (PG8_LAS unsigned*)(lds + (bufoff) + ldsw + _i * 8192), 16, 0, 0); } while (0)
#define PG8_STAGE1(bufoff, gbase, voff, pstep) do { unsigned vo_ = (voff); asm volatile("" : "+v"(vo_));     \
        _Pragma("unroll") for (int _i = 0; _i < 2; ++_i) \
        __builtin_amdgcn_global_load_lds((const unsigned*)((const char*)(gbase) + _i * (pstep) + vo_), (PG8_LAS unsigned*)(lds + (bufoff) + ldsw + _i * 8192), 16, 0, 0); } while (0)
#define PG8_STAGE(bufoff, gbase, voffB_) PG8_STAGE1(bufoff, gbase, voffB, pstepB)
#define PG8_STGA(bufoff, gbase, h, v0, v1) do { if constexpr (Sched::GATHER) { if ((h) == 0) PG8_STAGE2(bufoff, gbase, v0); else PG8_STAGE2(bufoff, gbase, v1); } else { PG8_STAGE1(bufoff, (gbase) + (h) * hstepA, voffA, pstepA); } } while (0)
#define PG8_LDA(dst, b, h) do { _Pragma("unroll") for (int m = 0; m < 4; ++m) _Pragma("unroll") for (int k = 0; k < 2; ++k) dst[m][k] = *(const PG8_LAS bf16x8*)(lds + PG8_SA(b, h) + aoff + m * 2048 + k * 1024); } while (0)
#define PG8_LDB(dst, b, h) do { _Pragma("unroll") for (int n = 0; n < 2; ++n) _Pragma("unroll") for (int k = 0; k < 2; ++k) dst[n][k] = *(const PG8_LAS bf16x8*)(lds + PG8_SB(b, h) + boff + n * 2048 + k * 1024); } while (0)
#define PG8_MMA(ai, bj, At, Bt) do { __builtin_amdgcn_s_setprio(1); _Pragma("unroll") for (int m = 0; m < 4; ++m) _Pragma("unroll") for (int n = 0; n < 2; ++n) _Pragma("unroll") for (int k = 0; k < 2; ++k) { \
        if constexpr (Epi::I8) acc[ai][bj][m][n] = __builtin_bit_cast(f32x4, __builtin_amdgcn_mfma_i32_16x16x64_i8(__builtin_bit_cast(i32x4, Bt[n][k]), __builtin_bit_cast(i32x4, At[m][k]), __builtin_bit_cast(i32x4, acc[ai][bj][m][n]), 0, 0, 0)); \
        else acc[ai][bj][m][n] = __builtin_amdgcn_mfma_f32_16x16x32_bf16(Bt[n][k], At[m][k], acc[ai][bj][m][n], 0, 0, 0); } __builtin_amdgcn_s_setprio(0); } while (0)
#define PG8_WAIT_V(n) asm volatile("s_waitcnt vmcnt(" #n ")" ::: "memory")
#define PG8_WAIT_VR(FRESH) do { if constexpr ((FRESH) && Epi::NSTORE == 16) asm volatile("s_waitcnt vmcnt(24)" ::: "memory"); else if constexpr ((FRESH) && Epi::NSTORE == 8) asm volatile("s_waitcnt vmcnt(16)" ::: "memory"); else asm volatile("s_waitcnt vmcnt(8)" ::: "memory"); } while (0)
#define PG8_WAIT_L(n) asm volatile("s_waitcnt lgkmcnt(" #n ")" ::: "memory")
#define PG8_BAR __builtin_amdgcn_s_barrier()
#define PG8_SCHED __builtin_amdgcn_sched_barrier(0)
#define PG8_BODY(FRESH) do { \
            PG8_LDB(B0, 0, 0); PG8_LDB(B1, 0, 1); PG8_SCHED; PG8_LDA(At, 0, 0); if constexpr (!(FRESH)) PG8_STGA(PG8_SA(1, 1), a1, 1, cur.va0, cur.va1); \
            PG8_WAIT_VR(FRESH); PG8_WAIT_L(0); PG8_BAR; PG8_MMA(0, 0, At, B0); PG8_MMA(0, 1, At, B1); PG8_BAR; PG8_SCHED; \
            PG8_LDA(At, 0, 1); PG8_STAGE(PG8_SB(0, 0), b2, voffB); PG8_STAGE(PG8_SB(0, 1), b2 + hstepB, voffB); PG8_STGA(PG8_SA(0, 0), a2, 0, x0, x1); \
            PG8_WAIT_VR(FRESH); PG8_WAIT_L(0); PG8_BAR; PG8_MMA(1, 0, At, B0); PG8_MMA(1, 1, At, B1); PG8_BAR; PG8_SCHED; \
            PG8_LDB(B0, 1, 0); PG8_LDB(B1, 1, 1); PG8_SCHED; PG8_LDA(At, 1, 0); PG8_STGA(PG8_SA(0, 1), a2, 1, x0, x1); \
            PG8_WAIT_VR(FRESH); PG8_WAIT_L(0); PG8_BAR; PG8_MMA(0, 0, At, B0); PG8_MMA(0, 1, At, B1); PG8_BAR; PG8_SCHED; \
            PG8_LDA(At, 1, 1); PG8_STAGE(PG8_SB(1, 0), b3, voffB); PG8_STAGE(PG8_SB(1, 1), b3 + hstepB, voffB); PG8_STGA(PG8_SA(1, 0), a3, 0, x0, x1); \
            PG8_WAIT_V(8); PG8_WAIT_L(0); PG8_BAR; PG8_MMA(1, 0, At, B0); PG8_MMA(1, 1, At, B1); PG8_BAR; PG8_SCHED; } while (0)
    GUnit cur, nxt; int ui = 0;
    if (!S.next(0, cur)) return;
    f32x4 acc[2][2][4][2];
#pragma unroll
    for (int a = 0; a < 2; ++a)
#pragma unroll
        for (int b = 0; b < 2; ++b)
#pragma unroll
            for (int m = 0; m < 4; ++m)
#pragma unroll
                for (int n = 0; n < 2; ++n) acc[a][b][m][n] = (f32x4){0.f, 0.f, 0.f, 0.f};
    bf16x8 At[4][2], B0[2][2], B1[2][2];
    const char* cA = cur.A; const char* cB = cur.B;
    if constexpr (SP2) {
        PG8_STAGE(PG8_SB(0, 0), cB, voffB); PG8_STAGE(PG8_SB(0, 1), cB + hstepB, voffB); PG8_STGA(PG8_SA(0, 0), cA, 0, cur.va0, cur.va1); PG8_STGA(PG8_SA(0, 1), cA, 1, cur.va0, cur.va1);
        if (wr == 1) PG8_BAR;
        PG8_WAIT_V(2); PG8_BAR;
        PG8_STAGE(PG8_SB(1, 0), cB + kstep, voffB); PG8_STGA(PG8_SA(1, 0), cA + kstep, 0, cur.va0, cur.va1); PG8_STAGE(PG8_SB(1, 1), cB + hstepB + kstep, voffB);
        if constexpr (PRE) { PG8_STGA(PG8_SA(1, 1), cA + kstep, 1, cur.va0, cur.va1); PG8_WAIT_V(0); PG8_BAR; }
        else { PG8_WAIT_V(6); PG8_BAR; }
    }
    for (;;) {
        const bool has_next = S.next(ui + 1, nxt);
        const char* nA = has_next ? nxt.A : cA; const char* nB = has_next ? nxt.B : cB;
        if constexpr (Sched::GATHER) { if (!has_next) { nxt.va0[0] = cur.va0[0]; nxt.va0[1] = cur.va0[1]; nxt.va1[0] = cur.va1[0]; nxt.va1[1] = cur.va1[1]; } }
#define PG8_TRIP(FRESH) do { \
            const bool last = (t == nt - 2); \
            const char* a1 = cA + (size_t)(t + 1) * kstep; \
            const char* a2 = last ? nA : cA + (size_t)(t + 2) * kstep; const char* b2 = last ? nB : cB + (size_t)(t + 2) * kstep; \
            const char* a3 = a2 + kstep; const char* b3 = b2 + kstep; \
            unsigned x0[2], x1[2]; \
            if constexpr (Sched::GATHER) { x0[0] = last ? nxt.va0[0] : cur.va0[0]; x0[1] = last ? nxt.va0[1] : cur.va0[1]; x1[0] = last ? nxt.va1[0] : cur.va1[0]; x1[1] = last ? nxt.va1[1] : cur.va1[1]; } \
            PG8_BODY(FRESH); } while (0)
        if constexpr (SP2) {
            if constexpr (PRE) { { const int t = 0; PG8_TRIP(true); }
                for (int t = 2; t < nt; t += 2) PG8_TRIP(false); }
            else { for (int t = 0; t < nt; t += 2) PG8_TRIP(false); }
        }
        if constexpr (ALIGN_EPI) { if (wr == 0) PG8_BAR; }
        if constexpr (PRE) { if (has_next) PG8_STGA(PG8_SA(1, 1), nA + kstep, 1, nxt.va0, nxt.va1); }
        int tl_ = tid; asm volatile("" : "+v"(tl_)); const int fr = tl_ & 15, fq = (tl_ >> 4) & 3;
        if constexpr (Epi::I8) {
            const float* sap = E.sa_ptr(cur); const float* sbp = E.sb_ptr(cur);
            f32x4 sbv[2][2];
#pragma unroll
            for (int bj = 0; bj < 2; ++bj)
#pragma unroll
                for (int n = 0; n < 2; ++n) sbv[bj][n] = *(const f32x4*)((const char*)sbp + (unsigned)(bj * HALF + wc * 32 + 8 * fq + 4 * n) * 4u);
#pragma unroll
            for (int ai = 0; ai < 2; ++ai) {
                float sav[4];
#pragma unroll
                for (int m = 0; m < 4; ++m) sav[m] = *(const float*)((const char*)sap + (unsigned)(ai * HALF + wr * 64 + m * 16 + fr) * 4u);
#pragma unroll
                for (int m = 0; m < 4; ++m) { const float s = sav[m];
#pragma unroll
                    for (int bj = 0; bj < 2; ++bj)
#pragma unroll
                        for (int n = 0; n < 2; ++n) { const i32x4 iv = __builtin_bit_cast(i32x4, acc[ai][bj][m][n]);
                            acc[ai][bj][m][n] = (f32x4){(float)iv.x, (float)iv.y, (float)iv.z, (float)iv.w} * (sbv[bj][n] * s); } } }
        }
        E(acc, cur, wr, wc, fr, fq);
        if (!has_next) break;
#pragma unroll
        for (int a = 0; a < 2; ++a)
#pragma unroll
            for (int b = 0; b < 2; ++b)
#pragma unroll
                for (int m = 0; m < 4; ++m)
#pragma unroll
                    for (int n = 0; n < 2; ++n) acc[a][b][m][n] = (f32x4){0.f, 0.f, 0.f, 0.f};
        cur = nxt; cA = nA; cB = nB; ++ui;
        if constexpr (ALIGN_EPI) { if (wr == 1) PG8_BAR; }
    }
    PG8_WAIT_V(0);
    if constexpr (!ALIGN_EPI) { if (wr == 0) PG8_BAR; }
    PG8_BAR;
#undef PG8_SA
#undef PG8_SB
#undef PG8_STAGE
#undef PG8_STAGE1
#undef PG8_STAGE2
#undef PG8_STGA
#undef PG8_LDA
#undef PG8_LDB
#undef PG8_MMA
#undef PG8_WAIT_V
#undef PG8_WAIT_VR
#undef PG8_WAIT_L
#undef PG8_BAR
#undef PG8_SCHED
#undef PG8_BODY
#undef PG8_TRIP
}
}
#include <hip/hip_bf16.h>
#include <cmath>
namespace attn128 {
using bf16=__hip_bfloat16;
using bf16x8=__attribute__((ext_vector_type(8)))short;
using s16x4=__attribute__((ext_vector_type(4)))short;
using f32x16=__attribute__((ext_vector_type(16)))float;
using u32x4=__attribute__((ext_vector_type(4)))unsigned;
constexpr int NHEAD=16,SEQ=16384,D=64,DM=NHEAD*D;
constexpr int NW=8,QBLK=32,QB=QBLK*NW,KVBLK=64,NQB=SEQ/QB;
constexpr int ATTN_PITCH=DM, ATTN_UNIT_ROWS=QB;
__device__ __forceinline__ int crow(int r,int hi){return (r&3)+8*(r>>2)+4*hi;}
#define SBAR() __builtin_amdgcn_sched_barrier(0)
__device__ __forceinline__ void cmask(f32x16&p0,f32x16&p1,int jb,int qrel,int hi){
  const float NEG=-INFINITY; int kb=64*jb+4*hi;
  #pragma unroll
  for(int r=0;r<16;++r){int kv=kb+(r&3)+8*(r>>2); if(kv>qrel)p0[r]=NEG; if(kv+32>qrel)p1[r]=NEG;}
}

constexpr int NSLOT=3, SLOTB=8192;
constexpr int VSLOTB=2*SLOTB;
constexpr int LDS_K=0, LDS_V=NSLOT*SLOTB, LDS_WS=LDS_V+NSLOT*VSLOTB, LDS_OST=LDS_WS+NW*64*4, LDS_BYTES=LDS_OST+NW*4096;
constexpr float C2=0.125f*1.4426950408889634f;
__device__ __forceinline__ void glds16(const void*sbase,unsigned voff,unsigned lds_dst){unsigned keep;
  asm volatile("s_mov_b32 %0, m0\n\ts_mov_b32 m0, %3\n\ts_nop 0\n\tglobal_load_lds_dwordx4 %1, %2\n\ts_mov_b32 m0, %0":"=&s"(keep):"v"(voff),"s"(sbase),"s"(lds_dst):"memory");}
__device__ __forceinline__ float max3f(float a,float b,float c){float r;asm("v_max3_f32 %0, %1, %2, %3":"=v"(r):"v"(a),"v"(b),"v"(c));return r;}
__device__ __forceinline__ float max2f(float a,float b){float r;asm("v_max_f32_e32 %0, %1, %2":"=v"(r):"v"(a),"v"(b));return r;}
__device__ __forceinline__ float fadd_s(float a,float b){float r;asm("v_add_f32_e32 %0, %1, %2":"=v"(r):"v"(a),"v"(b));return r;}
__device__ __forceinline__ float fsub_s(float a,float b){float r;asm("v_sub_f32_e32 %0, %1, %2":"=v"(r):"v"(a),"v"(b));return r;}
typedef float f32x2_t __attribute__((ext_vector_type(2))); typedef float f32x4_t __attribute__((ext_vector_type(4))); typedef __bf16 bf16x2_t __attribute__((ext_vector_type(2)));
__device__ __forceinline__ unsigned cvtpk_s(float lo,float hi){f32x2_t v={lo,hi};bf16x2_t b=__builtin_convertvector(v,bf16x2_t);return __builtin_bit_cast(unsigned,b);}
#define WAIT_BAR(N) asm volatile("s_waitcnt vmcnt(" #N ") lgkmcnt(0)\n\ts_barrier":::"memory")

__device__ __forceinline__ void qkt(f32x16&p0,f32x16&p1,const char*Kslot,const bf16x8*qr,const f32x16&negm,int r32,int hi){
  const char*kb=Kslot+(r32>>4)*2048+hi*256+(r32&15)*16;
  #pragma unroll
  for(int d0=0;d0<4;++d0){
    const bf16x8 b0=*reinterpret_cast<const bf16x8*>(kb+d0*512);
    const bf16x8 b1=*reinterpret_cast<const bf16x8*>(kb+d0*512+4096);
    if(d0==0){p0=__builtin_amdgcn_mfma_f32_32x32x16_bf16(b0,qr[0],negm,0,0,0);p1=__builtin_amdgcn_mfma_f32_32x32x16_bf16(b1,qr[0],negm,0,0,0);}
    else{p0=__builtin_amdgcn_mfma_f32_32x32x16_bf16(b0,qr[d0],p0,0,0,0);p1=__builtin_amdgcn_mfma_f32_32x32x16_bf16(b1,qr[d0],p1,0,0,0);}}
}
typedef __attribute__((address_space(3))) const char* lds_cptr;
typedef short v4i16_t __attribute__((ext_vector_type(4)));
__device__ __forceinline__ void kload8(bf16x8*kf,lds_cptr kp){
  kf[0]=*(const __attribute__((address_space(3))) bf16x8*)(kp);      kf[1]=*(const __attribute__((address_space(3))) bf16x8*)(kp+4096);
  kf[2]=*(const __attribute__((address_space(3))) bf16x8*)(kp+512);  kf[3]=*(const __attribute__((address_space(3))) bf16x8*)(kp+4608);
  kf[4]=*(const __attribute__((address_space(3))) bf16x8*)(kp+1024); kf[5]=*(const __attribute__((address_space(3))) bf16x8*)(kp+5120);
  kf[6]=*(const __attribute__((address_space(3))) bf16x8*)(kp+1536); kf[7]=*(const __attribute__((address_space(3))) bf16x8*)(kp+5632);
}
__device__ __forceinline__ void kload2(bf16x8*kf,lds_cptr kp,int j){ kf[2*j]=*(const __attribute__((address_space(3))) bf16x8*)(kp+j*512); kf[2*j+1]=*(const __attribute__((address_space(3))) bf16x8*)(kp+j*512+4096); }
__device__ __forceinline__ s16x4 vtr(lds_cptr p){ return __builtin_bit_cast(s16x4,__builtin_amdgcn_ds_read_tr16_b64_v4i16((__attribute__((address_space(3))) v4i16_t*)p)); }
__device__ __forceinline__ float rowmax(const f32x16&p0,const f32x16&p1){
  float a=max3f(p0[0],p0[1],p1[0]),b=max3f(p0[2],p0[3],p1[1]);a=max3f(a,p1[2],p1[3]);
  #pragma unroll
  for(int r=4;r<16;r+=4){a=max3f(a,p0[r],p0[r+1]);b=max3f(b,p0[r+2],p0[r+3]);a=max3f(a,p1[r],p1[r+1]);b=max3f(b,p1[r+2],p1[r+3]);}
  const float m=max2f(a,b);
  auto rr=__builtin_amdgcn_permlane32_swap(__float_as_uint(m),__float_as_uint(m),false,false);
  return max2f(__uint_as_float(rr[0]),__uint_as_float(rr[1]));
}
__device__ __forceinline__ void pv(f32x16*o,int vb,bf16x8 pa0,bf16x8 pa1,bf16x8 pa2,bf16x8 pa3){
  #pragma unroll
  for(int d0=0;d0<4;++d0){s16x4 lo[4],hi[4];
    #pragma unroll
    for(int ks=0;ks<4;++ks){
      asm volatile("ds_read_b64_tr_b16 %0,%1 offset:%c2":"=&v"(lo[ks]):"v"(vb),"i"(d0*4096+ks*1024):"memory");
      asm volatile("ds_read_b64_tr_b16 %0,%1 offset:%c2":"=&v"(hi[ks]):"v"(vb),"i"(d0*4096+ks*1024+512):"memory");}
    asm volatile("s_waitcnt lgkmcnt(0)":::"memory");SBAR();
    #define PK(k) (bf16x8){lo[k][0],lo[k][1],lo[k][2],lo[k][3],hi[k][0],hi[k][1],hi[k][2],hi[k][3]}
    o[d0]=__builtin_amdgcn_mfma_f32_32x32x16_bf16(pa0,PK(0),o[d0],0,0,0);
    o[d0]=__builtin_amdgcn_mfma_f32_32x32x16_bf16(pa1,PK(1),o[d0],0,0,0);
    o[d0]=__builtin_amdgcn_mfma_f32_32x32x16_bf16(pa2,PK(2),o[d0],0,0,0);
    o[d0]=__builtin_amdgcn_mfma_f32_32x32x16_bf16(pa3,PK(3),o[d0],0,0,0);
    #undef PK
  }
}

#ifndef ATTN_STORE16
#define ATTN_STORE16(p,v) (*(u32x4*)(p)=(v))
#endif
template<int THRL,int MODE> __device__ __forceinline__ void attn_unit128(int qb,const bf16*Qh,const bf16*__restrict__ Kh,const bf16*__restrict__ Vh,bf16*Oh,char*shm,const int tid,const float lam,const float*gsc){
  const int lane=tid&63,r32=lane&31,hi=lane>>5; const int wid=__builtin_amdgcn_readfirstlane(tid>>6);
  const int q0=qb*QB;
  const bf16*Qw=Qh+(long)(q0+wid*QBLK)*DM;
  const unsigned lds0=(unsigned)(uintptr_t)shm;
  float*wsf=(float*)(shm+LDS_WS)+wid*64;
  const unsigned koff=(unsigned)((16*(wid>>1)+(lane&15))*DM+(4*(wid&1)+(lane>>4))*8)*2u, voff=(unsigned)((16*(wid&3)+(lane>>2))*DM+(wid>>2)*32+(lane&3)*8)*2u;
  const unsigned kdst=lds0+LDS_K+wid*1024, vdst=lds0+LDS_V+wid*1024;
  #define DMA_K(t,slot) glds16((const char*)Kh+(size_t)(t)*(KVBLK*DM*2),koff,(unsigned)__builtin_amdgcn_readfirstlane(kdst+(slot)))
  #define DMA_V(t,slot) do{ glds16((const char*)Vh+(size_t)(t)*(KVBLK*DM*2),voff,(unsigned)__builtin_amdgcn_readfirstlane(vdst+2*(slot))); glds16((const char*)Vh+128+(size_t)(t)*(KVBLK*DM*2),voff,(unsigned)__builtin_amdgcn_readfirstlane(vdst+2*(slot)+8192)); }while(0)
  const char*Kbase=shm+LDS_K; bf16x8 kf[8];
  const lds_cptr shm3=(lds_cptr)shm; const lds_cptr kp0=shm3+LDS_K+(r32>>4)*2048+hi*256+(r32&15)*16; const lds_cptr vp0=shm3+LDS_V+((lane>>4)&1)*32+(lane&3)*8+(4*hi+((lane&15)>>2))*64;
  const int NT=(q0+QB)/KVBLK;
  DMA_K(0,0);DMA_V(0,0);DMA_K(1,SLOTB);
  bf16x8 qr[4];
  #pragma unroll
  for(int d0=0;d0<4;++d0)qr[d0]=*reinterpret_cast<const bf16x8*>(&Qw[(long)r32*DM+d0*16+hi*8]);
  float mhat=0.f,l_reg=0.f;f32x16 o[4];o[0]=f32x16{};o[1]=f32x16{};o[2]=f32x16{};o[3]=f32x16{};f32x16 negm=f32x16{};asm volatile("":"+v"(negm));
  const int qrel=wid*QBLK+r32;
  #define CMASK(P0,P1,t) do{int jb_=(t)-(NT-4); if(jb_>=0)cmask(P0,P1,jb_,qrel,hi);}while(0)
  bool resc=false;
  #define START(P0,P1) do{ const float rm=rowmax(P0,P1); resc=false; \
    { const float dl=rm; mhat=fadd_s(mhat,dl); \
      _Pragma("unroll") for(int r=0;r<16;++r){P0[r]=fsub_s(P0[r],dl);P1[r]=fsub_s(P1[r],dl);} \
      _Pragma("unroll") for(int r=0;r<16;++r)negm[r]=-mhat; asm volatile("":"+v"(negm)); } \
    _Pragma("unroll") for(int r=0;r<16;++r)P0[r]=__builtin_amdgcn_exp2f(P0[r]); }while(0)
  #define RESC() do{ if(resc){ asm volatile("s_waitcnt lgkmcnt(0)":::"memory"); \
      _Pragma("unroll") for(int d_=0;d_<4;++d_) _Pragma("unroll") for(int r=0;r<16;++r)o[d_][r]*=wsf[crow(r,hi)]; } }while(0)
  f32x16 pA0,pA1,pB0,pB1;
  int sl_prev=0,sl_cur=0,sl_next=SLOTB;
  #define ROT() do{sl_prev=sl_cur;sl_cur=sl_next;sl_next=(sl_next==(NSLOT-1)*SLOTB)?0:sl_next+SLOTB;}while(0)
  DMA_K(2,2*SLOTB);
  WAIT_BAR(3);
  qkt(pA0,pA1,Kbase,qr,negm,r32,hi);asm volatile("s_nop 15\n\ts_nop 7":"+v"(pA0),"+v"(pA1));CMASK(pA0,pA1,0);
  START(pA0,pA1);
  _Pragma("unroll") for(int r=0;r<16;++r)pA1[r]=__builtin_amdgcn_exp2f(pA1[r]);
  WAIT_BAR(0);
  DMA_K(3,0);DMA_V(1,SLOTB);
  ROT();
  kload8(kf,kp0+sl_cur);
  WAIT_BAR(3);
  s16x4 vlo[4],vhi[4]; u32x4 pw0,pw1,pw2,pw3;
  #define PKW(P,B) cvtpk_s(P[B],P[B+1])
  #define PAF(k) __builtin_bit_cast(bf16x8,pw##k)
  #define VFR(s) (bf16x8){vlo[s][0],vlo[s][1],vlo[s][2],vlo[s][3],vhi[s][0],vhi[s][1],vhi[s][2],vhi[s][3]}
  #define PIN(x) asm volatile("":"+v"(x))
  #define MX3(a,b,c) __builtin_fmaxf(__builtin_fmaxf((a),(b)),(c))
  #define GAPA(MF,A0,A1,A2,A3,W0,W1,PW) do{ MF; sacc+=A0; sacc+=A1; sacc+=A2; sacc+=A3; PIN(sacc); W0; W1; PIN(PW); SBAR(); }while(0)
  #define EX(v) __builtin_amdgcn_exp2f(v)
  #define GAPB(MF,X,B) do{ MF; X[B]=EX(X[B]); X[B+1]=EX(X[B+1]); PIN(X); SBAR(); }while(0)
  #define VRD(i,s) do{ vlo[s]=vtr(vp_+(((i)>>2)*4096+((i)&3)*1024)); vhi[s]=vtr(vp_+(((i)>>2)*4096+((i)&3)*1024+512)); SBAR(); }while(0)
  #define KRD(G,j) do{ if(G){ kload2(kf,kp0+sl_next,j); SBAR(); } }while(0)
  #define PVM(g,k,s) o[g]=MFMA_(PAF(k),VFR(s),o[g],0,0,0)
  #define MFMA_ __builtin_amdgcn_mfma_f32_32x32x16_bf16
  #define STEP(C0,C1,P0,P1,t,GK,GV,GL) do{ SBAR(); \
    const lds_cptr vp_=vp0+2*sl_prev; \
    float sacc=(P0[0]+P0[1]); \
    GAPA(C0=MFMA_(kf[0],qr[0],negm,0,0,0), P0[2],P0[3],P0[4],P0[5],     pw0[0]=PKW(P0,0), pw0[1]=PKW(P0,2), pw0); \
    GAPA(C1=MFMA_(kf[1],qr[0],negm,0,0,0), P0[6],P0[7],P0[8],P0[9],     pw0[2]=PKW(P0,4), pw0[3]=PKW(P0,6), pw0); \
    GAPA(C0=MFMA_(kf[2],qr[1],C0,0,0,0),   P0[10],P0[11],P0[12],P0[13], pw1[0]=PKW(P0,8), pw1[1]=PKW(P0,10), pw1); \
    GAPA(C1=MFMA_(kf[3],qr[1],C1,0,0,0),   P0[14],P0[15],P1[0],P1[1],   pw1[2]=PKW(P0,12),pw1[3]=PKW(P0,14), pw1); \
    GAPA(C0=MFMA_(kf[4],qr[2],C0,0,0,0),   P1[2],P1[3],P1[4],P1[5],     pw2[0]=PKW(P1,0), pw2[1]=PKW(P1,2), pw2); \
    VRD(0,0); GAPA(C1=MFMA_(kf[5],qr[2],C1,0,0,0),   P1[6],P1[7],P1[8],P1[9],     pw2[2]=PKW(P1,4), pw2[3]=PKW(P1,6), pw2); \
    VRD(4,1); GAPA(C0=MFMA_(kf[6],qr[3],C0,0,0,0),   P1[10],P1[11],P1[12],P1[13], pw3[0]=PKW(P1,8), pw3[1]=PKW(P1,10), pw3); \
    VRD(8,2); GAPA(C1=MFMA_(kf[7],qr[3],C1,0,0,0),   P1[14],P1[15],0.f,0.f,       pw3[2]=PKW(P1,12),pw3[3]=PKW(P1,14), pw3); \
    l_reg+=sacc; \
    if(GK){DMA_K((t)+3,sl_cur);} if(GV){DMA_V((t)+1,sl_next);} \
    CMASK(C0,C1,t); \
    { float a=MX3(C0[0],C0[1],C1[0]),b=MX3(C0[2],C0[3],C1[1]); a=MX3(a,C1[2],C1[3]); \
      _Pragma("unroll") for(int r=4;r<16;r+=4){a=MX3(a,C0[r],C0[r+1]);b=MX3(b,C0[r+2],C0[r+3]);a=MX3(a,C1[r],C1[r+1]);b=MX3(b,C1[r+2],C1[r+3]);} \
      float rm=__builtin_fmaxf(a,b); { auto rr=__builtin_amdgcn_permlane32_swap(__float_as_uint(rm),__float_as_uint(rm),false,false); rm=__builtin_fmaxf(__uint_as_float(rr[0]),__uint_as_float(rr[1])); } \
      resc=false; \
      if(__builtin_expect(__any(rm>(float)THRL),0)){ const float dl=__builtin_fmaxf(rm,0.f); mhat+=dl; \
        _Pragma("unroll") for(int r=0;r<16;++r){C0[r]-=dl;C1[r]-=dl;} \
        _Pragma("unroll") for(int r=0;r<16;++r)negm[r]=-mhat; asm volatile("":"+v"(negm)); \
        const float f=__builtin_amdgcn_exp2f(-dl); l_reg*=f; if(hi==0)wsf[r32]=f; resc=true; } } \
    SBAR(); \
    VRD(12,3);            GAPB(PVM(0,0,0), C0,0); \
    VRD(1,0);             GAPB(PVM(1,0,1), C0,2); \
    VRD(5,1);             GAPB(PVM(2,0,2), C0,4); \
    VRD(9,2);             GAPB(PVM(3,0,3), C0,6); \
    VRD(13,3); KRD(GL,0); GAPB(PVM(0,1,0), C0,8); \
    VRD(2,0);             GAPB(PVM(1,1,1), C0,10); \
    VRD(6,1);  KRD(GL,1); GAPB(PVM(2,1,2), C0,12); \
    VRD(10,2);            GAPB(PVM(3,1,3), C0,14); \
    VRD(14,3); KRD(GL,2); GAPB(PVM(0,2,0), C1,0); \
    VRD(3,0);             GAPB(PVM(1,2,1), C1,2); \
    VRD(7,1);  KRD(GL,3); GAPB(PVM(2,2,2), C1,4); \
    VRD(11,2);            GAPB(PVM(3,2,3), C1,6); \
    VRD(15,3);            GAPB(PVM(0,3,0), C1,8); \
                          GAPB(PVM(1,3,1), C1,10); \
                          GAPB(PVM(2,3,2), C1,12); \
                          GAPB(PVM(3,3,3), C1,14); \
    }while(0)
  int t=1;
  #undef CMASK
  #define CMASK(P0,P1,t) do{}while(0)
  for(;t+5<NT;t+=2){
    STEP(pB0,pB1,pA0,pA1,t,true,true,true);     WAIT_BAR(3); RESC(); ROT();
    STEP(pA0,pA1,pB0,pB1,t+1,true,true,true);   WAIT_BAR(3); RESC(); ROT();
  }
  #undef CMASK
  #define CMASK(P0,P1,t) do{int jb_=(t)-(NT-4); if(jb_>=0)cmask(P0,P1,jb_,qrel,hi);}while(0)
  #define ENDW(tt) do{ if((tt)+3<NT){WAIT_BAR(3);} else if((tt)+2<NT){WAIT_BAR(2);} else {WAIT_BAR(0);} }while(0)
  for(;t+1<NT;t+=2){
    STEP(pB0,pB1,pA0,pA1,t,(t+3<NT),(t+1<NT),(t+1<NT));       ENDW(t);   RESC(); ROT();
    STEP(pA0,pA1,pB0,pB1,t+1,(t+4<NT),(t+2<NT),(t+2<NT));     ENDW(t+1); RESC(); ROT();
  }
  STEP(pB0,pB1,pA0,pA1,NT-1,false,false,false); RESC();
  { float sacc=pB0[0]+pB0[1]; _Pragma("unroll") for(int r=2;r<16;++r)sacc+=pB0[r]; _Pragma("unroll") for(int r=0;r<16;++r)sacc+=pB1[r]; l_reg+=sacc;
    pw0=(u32x4){PKW(pB0,0),PKW(pB0,2),PKW(pB0,4),PKW(pB0,6)};pw1=(u32x4){PKW(pB0,8),PKW(pB0,10),PKW(pB0,12),PKW(pB0,14)};pw2=(u32x4){PKW(pB1,0),PKW(pB1,2),PKW(pB1,4),PKW(pB1,6)};pw3=(u32x4){PKW(pB1,8),PKW(pB1,10),PKW(pB1,12),PKW(pB1,14)};
    SBAR(); const int vb0=(int)(lds0+LDS_V)+((lane>>4)&1)*32+(lane&3)*8+(4*hi+((lane&15)>>2))*64; pv(o,vb0+2*sl_cur,PAF(0),PAF(1),PAF(2),PAF(3)); }
  #undef PKW
  #undef PAF
  #undef VFR
  #undef PIN
  #undef MX3
  #undef GAPA
  #undef GAPB
  #undef EX
  #undef VRD
  #undef KRD
  #undef STEP
  #undef PVM
  #undef MFMA_
  #undef ENDW
  {auto rr=__builtin_amdgcn_permlane32_swap(__float_as_uint(l_reg),__float_as_uint(l_reg),false,false);l_reg=__uint_as_float(rr[0])+__uint_as_float(rr[1]);}
  if(hi==0)wsf[32+r32]=l_reg;asm volatile("s_waitcnt lgkmcnt(0)":::"memory");
  float rli[16];
  #pragma unroll
  for(int r=0;r<16;++r)rli[r]=__builtin_amdgcn_rcpf(wsf[32+crow(r,hi)]);
  bf16*Ow=Oh+(long)(q0+wid*QBLK)*DM;
  if constexpr(MODE==0){ bf16*stg=(bf16*)(shm+LDS_OST)+wid*2048;
    #pragma unroll
    for(int hf=0;hf<2;++hf){
      #pragma unroll
      for(int r=0;r<16;++r){const int orow=crow(r,hi);
        #pragma unroll
        for(int d0=0;d0<2;++d0)stg[orow*64+d0*32+r32]=__float2bfloat16(o[2*hf+d0][r]*rli[r]);}
      asm volatile("s_waitcnt lgkmcnt(0)":::"memory");
      #pragma unroll
      for(int i=0;i<4;++i){const int row=i*8+(lane>>3),ch=lane&7; const u32x4 v=*(const u32x4*)(stg+row*64+ch*8); ATTN_STORE16(Ow+(long)row*DM+hf*64+ch*8,v);}
      asm volatile("s_waitcnt lgkmcnt(0)":::"memory");
    } }
  else {
    asm volatile("s_waitcnt lgkmcnt(0)\n\ts_barrier":::"memory");
    bf16*stg=(bf16*)(shm+LDS_K)+wid*4096;
    #pragma unroll
    for(int r=0;r<16;++r){const int orow=crow(r,hi);
      #pragma unroll
      for(int d0=0;d0<4;++d0)stg[orow*128+d0*32+r32]=__float2bfloat16(o[d0][r]*rli[r]);}
    asm volatile("s_waitcnt lgkmcnt(0)":::"memory");
    const int rq=lane>>4,ch=lane&15;
    u32x4 a[8],b[8];
    #pragma unroll
    for(int k=0;k<8;++k){const int row=4*k+rq; a[k]=*(const u32x4*)(Ow+(long)row*DM+ch*8); b[k]=*(const u32x4*)(stg+row*128+ch*8);}
    const f32x4_t g0=*(const f32x4_t*)(gsc+8*ch),g1=*(const f32x4_t*)(gsc+8*ch+4);
    #pragma unroll
    for(int k=0;k<8;++k){ float dd[8],ss=0.f;
      #pragma unroll
      for(int i=0;i<4;++i){const unsigned ua=a[k][i],ub=b[k][i];
        const float d0=__uint_as_float(ua<<16)-lam*__uint_as_float(ub<<16),d1=__uint_as_float(ua&0xffff0000u)-lam*__uint_as_float(ub&0xffff0000u);
        dd[2*i]=d0;dd[2*i+1]=d1;ss+=d0*d0+d1*d1;}
      ss+=__int_as_float(__builtin_amdgcn_update_dpp(0,__float_as_int(ss),0xB1,0xF,0xF,true));
      ss+=__int_as_float(__builtin_amdgcn_update_dpp(0,__float_as_int(ss),0x4E,0xF,0xF,true));
      ss+=__int_as_float(__builtin_amdgcn_update_dpp(0,__float_as_int(ss),0x141,0xF,0xF,true));
      ss+=__int_as_float(__builtin_amdgcn_update_dpp(0,__float_as_int(ss),0x140,0xF,0xF,true));
      const float rs=1.0f/sqrtf(ss*(1.0f/128.0f)+1e-6f);
      u32x4 w;w[0]=cvtpk_s(dd[0]*rs*g0[0],dd[1]*rs*g0[1]);w[1]=cvtpk_s(dd[2]*rs*g0[2],dd[3]*rs*g0[3]);w[2]=cvtpk_s(dd[4]*rs*g1[0],dd[5]*rs*g1[1]);w[3]=cvtpk_s(dd[6]*rs*g1[2],dd[7]*rs*g1[3]);
      ATTN_STORE16(Ow+(long)(4*k+rq)*DM+ch*8,w);}
  }
  asm volatile("s_waitcnt lgkmcnt(0)\n\ts_barrier":::"memory");
  #undef DMA_K
  #undef DMA_V
  #undef CMASK
  #undef START
  #undef RESC
  #undef ROT
}
constexpr int ATTN_LDS_BYTES=LDS_BYTES;
#undef SBAR
#undef WAIT_BAR
}

constexpr int NWAVES = 8;
#ifndef MK_ONE_LAUNCH
#define MK_ONE_LAUNCH 1
#endif

constexpr int NB = 2, SEQ = 16384, DM = 1024, NTOK = NB * SEQ, NLAYER = 2, INW = 9216;
constexpr int NEXP = 16, DEXP = 512, MOE_ROWS = 2 * NTOK + NEXP * 256;
constexpr float EPSN = 1e-6f;
constexpr float LOG2E = 1.4426950408889634f;

constexpr size_t MiB = 1u << 20;
constexpr size_t WS_CTL = 0, CTL_ZERO_BYTES = 1 * MiB;
constexpr size_t WS_MOD = 1 * MiB;
constexpr size_t WS_COS = 2 * MiB, WS_SIN = 4 * MiB;
constexpr size_t WS_SCANA = 6 * MiB, WS_SCANH = 8 * MiB;
constexpr size_t WS_TOKE = 7 * MiB, WS_TOKP = 7 * MiB + 512 * 1024;
constexpr size_t WS_INV = 10 * MiB, WS_WTAB = 12 * MiB;
constexpr size_t WS_XS = 9 * MiB + 512 * 1024, WS_XSA = 9 * MiB + 768 * 1024;
constexpr size_t WS_STAB = 14 * MiB;
constexpr size_t WS_GSC = 9 * MiB;
constexpr size_t WS_W = 16 * MiB, W_LAYER = 18 * MiB;
constexpr size_t WS_SLOTS_ = 52 * MiB;
constexpr size_t W_IN = 0, W_BR = 9 * MiB, W_OUT = 15 * MiB, W_LRU = 17 * MiB, W_SB = 17 * MiB + 512 * 1024;
constexpr size_t WS_POOLTMP = WS_SLOTS_ + 2 * (32u << 20);
constexpr size_t WS_SLOTS = 52 * MiB, SLOT = 32 * MiB;
constexpr size_t WS_XB = WS_SLOTS + 12 * SLOT;
constexpr size_t WS_END = WS_XB + 64 * MiB;
enum { S_XN = 0, S_XLRU = 1, S_Y = 2, S_Z = 3, S_Q = 4, S_K = 5, S_V = 6, S_G0 = 7, S_XC = 10, S_BRPOOL = 11,
       S_LA = 1, S_V2 = 3, S_O0 = 10, S_MERGED = 4 };
constexpr size_t MOE_XN = WS_SLOTS, MOE_AG = WS_SLOTS + 2 * SLOT, MOE_ACT = WS_SLOTS + 7 * SLOT, MOE_WGU = WS_SLOTS + 10 * SLOT, MOE_WD = WS_SLOTS + 11 * SLOT;
constexpr size_t MOE_SB = MOE_WGU + 16 * MiB;
static_assert(WS_SLOTS == WS_SLOTS_, "slots base");
static_assert((size_t)MOE_ROWS * DM * 2 <= 5 * SLOT && (size_t)MOE_ROWS * DEXP * 2 <= 3 * SLOT, "MoE overlay");
constexpr int CW_TMO = 0, CW_CODE = 1, CW_BAR = 4096, CW_EXPCNT = 16384, CW_SCANF = 32768;

constexpr int RING_OFF = 0, RING_BYTES = 131072;
constexpr int LDSCTL_OFF = RING_BYTES, MISC_OFF = LDSCTL_OFF + 320;
constexpr int LDS_BYTES = 147456;

#define GAS __attribute__((address_space(1)))
#define LAS __attribute__((address_space(3)))
typedef unsigned short bf16;
typedef unsigned v4u __attribute__((ext_vector_type(4)));
typedef unsigned v2u __attribute__((ext_vector_type(2)));
typedef float f32x4 __attribute__((ext_vector_type(4)));
typedef float f32x2 __attribute__((ext_vector_type(2)));
typedef GAS unsigned gu32;
#define RLX_AGENT __ATOMIC_RELAXED, __HIP_MEMORY_SCOPE_AGENT
#define LDS_WAIT() asm volatile("s_waitcnt lgkmcnt(0)" ::: "memory")
#define VM_WAIT() asm volatile("s_waitcnt vmcnt(0)" ::: "memory")
__device__ __forceinline__ unsigned pk2(float lo, float hi) { return pg8::cvt_pk_bf16(lo, hi); }
__device__ __forceinline__ float bflo(unsigned w) { return __uint_as_float(w << 16); }
__device__ __forceinline__ float bfhi(unsigned w) { return __uint_as_float(w & 0xffff0000u); }
__device__ __forceinline__ float fexp2(float x) { return __builtin_amdgcn_exp2f(x); }
__device__ __forceinline__ float frcp(float x) { return __builtin_amdgcn_rcpf(x); }
__device__ __forceinline__ float sigmoidf_(float z) { return frcp(1.0f + fexp2(-z * LOG2E)); }
__device__ __forceinline__ float gelu_tanh(float x) { const float u = 0.7978845608028654f * (x + 0.044715f * x * x * x); return x * frcp(1.0f + fexp2(-2.0f * LOG2E * u)); }
__device__ __forceinline__ float shx(float v, int lane, int o) { return __int_as_float(__builtin_amdgcn_ds_bpermute((lane ^ o) << 2, __float_as_int(v))); }
__device__ __forceinline__ int shi(int v, int src) { return __builtin_amdgcn_ds_bpermute(src << 2, v); }
__device__ __forceinline__ float red16(float (&t)[16]) {
#pragma unroll
    for (int j = 0; j < 8; ++j) { const auto r = __builtin_amdgcn_permlane32_swap(__float_as_uint(t[j]), __float_as_uint(t[j + 8]), false, false); t[j] = __uint_as_float(r[0]) + __uint_as_float(r[1]); }
#pragma unroll
    for (int j = 0; j < 4; ++j) { const auto r = __builtin_amdgcn_permlane16_swap(__float_as_uint(t[j]), __float_as_uint(t[j + 4]), false, false); t[j] = __uint_as_float(r[0]) + __uint_as_float(r[1]); }
#pragma unroll
    for (int j = 0; j < 2; ++j) { const int a = __float_as_int(t[j]), b = __float_as_int(t[j + 2]);
        const int x = __builtin_amdgcn_update_dpp(b, a, 0x140, 0xF, 0x3, false), y = __builtin_amdgcn_update_dpp(a, b, 0x140, 0xF, 0xC, false); t[j] = __int_as_float(y) + __int_as_float(x); }
    { const int a = __float_as_int(t[0]), b = __float_as_int(t[1]);
        const int x = __builtin_amdgcn_update_dpp(b, a, 0x141, 0xF, 0x5, false), y = __builtin_amdgcn_update_dpp(a, b, 0x141, 0xF, 0xA, false); t[0] = __int_as_float(y) + __int_as_float(x); }
    float v = t[0];
    v += __int_as_float(__builtin_amdgcn_update_dpp(0, __float_as_int(v), 0x4E, 0xF, 0xF, true));
    v += __int_as_float(__builtin_amdgcn_update_dpp(0, __float_as_int(v), 0xB1, 0xF, 0xF, true));
    return v;
}
__device__ __forceinline__ float wave_sum(float v, int lane) {
#pragma unroll
    for (int o = 1; o < 64; o <<= 1) v += shx(v, lane, o);
    return v;
}

__device__ __forceinline__ float wave_max(float v, int lane) {
#pragma unroll
    for (int o = 1; o < 64; o <<= 1) v = fmaxf(v, shx(v, lane, o));
    return v;
}
__device__ __forceinline__ unsigned pack_i8x4(float a, float b, float c, float d) {
    const int q0 = (int)rintf(a), q1 = (int)rintf(b), q2 = (int)rintf(c), q3 = (int)rintf(d);
    return (unsigned)(q0 & 0xff) | ((unsigned)(q1 & 0xff) << 8) | ((unsigned)(q2 & 0xff) << 16) | ((unsigned)q3 << 24);
}
__device__ __forceinline__ float quant_row_store(const f32x4 (&y)[4], int lane, unsigned char* dst, float* scale_slot) {
    float am = 0.f;
#pragma unroll
    for (int j = 0; j < 4; ++j) am = fmaxf(fmaxf(am, fmaxf(fabsf(y[j].x), fabsf(y[j].y))), fmaxf(fabsf(y[j].z), fabsf(y[j].w)));
    am = wave_max(am, lane);
    const float inv = am > 0.f ? 127.0f / am : 0.f, sc = am * (1.0f / 127.0f);
#pragma unroll
    for (int j = 0; j < 4; ++j) *(unsigned*)(dst + 4 * lane + 256 * j) = pack_i8x4(y[j].x * inv, y[j].y * inv, y[j].z * inv, y[j].w * inv);
    if (lane == 0) *scale_slot = sc;
    return sc;
}

#define XB_TMO      128
#define XB_XCNT(j)  (256  + 64 * (j))
#define XB_XSUB(j)  (1280 + 64 * (j))
#define XB_XGEN(j)  (2304 + 64 * (j))
#define XB_TOP      3328
#define XB_TOPGEN   3392
#define XCD_BAR_WORDS 3456
#define XB_SPIN_CAP (1u << 18)

__device__ __forceinline__ unsigned xb_ld(unsigned* p)              { return __hip_atomic_load(p, __ATOMIC_RELAXED, __HIP_MEMORY_SCOPE_AGENT); }
__device__ __forceinline__ unsigned xb_add(unsigned* p, unsigned v) { return __hip_atomic_fetch_add(p, v, __ATOMIC_RELAXED, __HIP_MEMORY_SCOPE_AGENT); }
__device__ __forceinline__ unsigned xb_xcc_id() { return (unsigned)__builtin_amdgcn_s_getreg((3 << 11) | 20) & 0xFu; }
#define XB_SPIN(cond, bar) do { unsigned _sp = 0; while (cond) { __builtin_amdgcn_s_sleep(1); \
    if ((++_sp & 255u) == 0u) { if (xb_ld(&(bar)[XB_TMO])) break; if (_sp > XB_SPIN_CAP) { atomicAdd(&(bar)[XB_TMO], 1u); break; } } } } while (0)

struct XcdBarrier {
    unsigned* bar; unsigned x;
    volatile LAS unsigned* st;
};

__device__ __forceinline__ XcdBarrier xcd_barrier_post(unsigned* bar, volatile LAS unsigned* st) {
    XcdBarrier b; b.bar = bar; b.x = xb_xcc_id(); b.st = st;
    if (threadIdx.x == 0) (void)xb_add(&bar[XB_XCNT(b.x)], 1u);
    return b;
}
__device__ __forceinline__ void xcd_barrier_complete(unsigned* bar, unsigned x, unsigned& nloc, unsigned& nx) {
    const unsigned G = gridDim.x * gridDim.y * gridDim.z;
    unsigned sum, cnt, mine, sp = 0u;
    for (;;) {
        sum = 0u; cnt = 0u; mine = 0u;
#pragma unroll
        for (unsigned j = 0; j < 16; ++j) { const unsigned c = xb_ld(&bar[XB_XCNT(j)]); sum += c; cnt += (c > 0u) ? 1u : 0u; mine = (j == x) ? c : mine; }
        if (sum == G) break;
        __builtin_amdgcn_s_sleep(1);
        if ((++sp & 255u) == 0u) { if (xb_ld(&bar[XB_TMO])) break; if (sp > XB_SPIN_CAP) { atomicAdd(&bar[XB_TMO], 1u); break; } }
    }
    nloc = mine > 0u ? mine : 1u; nx = cnt > 0u ? cnt : 1u;
}

__device__ __forceinline__ void xcd_barrier(const XcdBarrier& b) {
    asm volatile("s_waitcnt vmcnt(0)" ::: "memory");
    __syncthreads();
    if (threadIdx.x == 0) {
        unsigned* bar = b.bar;
        __builtin_amdgcn_s_waitcnt(0);
        unsigned nloc = b.st[0], nx = b.st[1];
        if (nloc == 0u) { xcd_barrier_complete(bar, b.x, nloc, nx); b.st[0] = nloc; b.st[1] = nx; }
        const unsigned old = xb_add(&bar[XB_XSUB(b.x)], 1u);
        const unsigned gen = old / nloc;
        if (old + 1u == (gen + 1u) * nloc) {
            __builtin_amdgcn_fence(__ATOMIC_RELEASE, "agent");
            asm volatile("s_waitcnt vmcnt(0)" ::: "memory");
            const unsigned og = xb_add(&bar[XB_TOP], 1u);
            const unsigned tg = og / nx;
            if (og + 1u == (tg + 1u) * nx) xb_add(&bar[XB_TOPGEN], 1u);
            else XB_SPIN(xb_ld(&bar[XB_TOPGEN]) == tg, bar);
            __builtin_amdgcn_fence(__ATOMIC_ACQUIRE, "agent");
            xb_add(&bar[XB_XGEN(b.x)], 1u);
            asm volatile("s_waitcnt vmcnt(0)" ::: "memory");
        } else {
            XB_SPIN(xb_ld(&bar[XB_XGEN(b.x)]) == gen, bar);
            __builtin_amdgcn_fence(__ATOMIC_ACQUIRE, "agent");
            asm volatile("s_waitcnt vmcnt(0)" ::: "memory");
        }
    }
    __syncthreads();
}

struct Args { const float* in[30]; float* out; unsigned char* ws; int ph_lo, ph_hi; };
static_assert(sizeof(Args) == 32 * 8 + 8, "Args has no padding");
enum { I_X = 0, I_C, I_WADA, I_BADA, I_N1G, I_N2G, I_WIN, I_CONVW, I_CONVB, I_LWA, I_LBA, I_LWX, I_LBX, I_LL, I_POOLW, I_POOLS, I_QNG, I_KNG,
       I_LQ1, I_LK1, I_LQ2, I_LK2, I_SUBLN, I_WBR, I_WOUT, I_RW, I_RB, I_WG, I_WU, I_WD };

typedef const __attribute__((address_space(4))) Args* KArgs;
__device__ __forceinline__ KArgs kargs() { KArgs p = (KArgs)__builtin_amdgcn_kernarg_segment_ptr(); asm volatile("" : "+s"(p)); return p; }
__device__ __forceinline__ const float* gin(KArgs ap, int i) { return (const float*)(const GAS float*)ap->in[i]; }
__device__ __forceinline__ float* gout(KArgs ap) { return (float*)(GAS float*)ap->out; }
struct Frame {
    LAS unsigned char* lds;
    unsigned char* ldsg;
    gu32* ctl;
    unsigned char* ws;
    int tid, lane, wave, vcu, G, bid;
};

__device__ __forceinline__ void transpose_item(const float* W, int ldw, int k0, int n0, bf16* dst, int ldd, LAS float* scr, int lane) {
    float tv[32];
#pragma unroll
    for (int i = 0; i < 32; ++i) tv[i] = W[(size_t)(k0 + 2 * i + (lane >> 5)) * ldw + n0 + (lane & 31)];
#pragma unroll
    for (int i = 0; i < 32; ++i) scr[(2 * i + (lane >> 5)) * 33 + (lane & 31)] = tv[i];
    LDS_WAIT(); asm volatile("" ::: "memory");
    const int c = lane & 7;
#pragma unroll
    for (int j = 0; j < 4; ++j) { const int n = (lane >> 3) + 8 * j; const LAS float* s = scr + (8 * c) * 33 + n;
        v4u o; o.x = pk2(s[0 * 33], s[1 * 33]); o.y = pk2(s[2 * 33], s[3 * 33]); o.z = pk2(s[4 * 33], s[5 * 33]); o.w = pk2(s[6 * 33], s[7 * 33]);
        *(v4u*)(dst + (size_t)n * ldd + k0 + 8 * c) = o; }
    LDS_WAIT(); asm volatile("" ::: "memory");
}
__device__ __forceinline__ void quant_cols_i8(const Frame& F, const float* W, int ldw, int n0, int K, unsigned char* dst, int ldd, float* sb) {
    LAS float* scr = (LAS float*)(F.lds + RING_OFF + F.wave * 16384); LAS float* red = (LAS float*)(F.lds + RING_OFF + 8 * 16384 - 1024);
    const int lane = F.lane, kw = K / 8, k0 = F.wave * kw;
    const unsigned rstep = (unsigned)ldw * 8u;
    const unsigned off0 = ((unsigned)(k0 + (lane >> 5)) * (unsigned)ldw + (unsigned)(n0 + (lane & 31))) * 4u;
    float am = 0.f, a[64];
#pragma unroll
    for (int u = 0; u < 64; ++u) a[u] = *(const float*)((const char*)W + off0 + (unsigned)u * rstep);
#pragma unroll
    for (int u = 0; u < 64; ++u) am = fmaxf(am, fabsf(a[u]));
    am = fmaxf(am, shx(am, lane, 32));
    __syncthreads();
    if (lane < 32) red[F.wave * 32 + lane] = am;
    __syncthreads();
#pragma unroll
    for (int w = 0; w < 8; ++w) am = fmaxf(am, red[w * 32 + (lane & 31)]);
    const float inv = am > 0.f ? 127.0f / am : 0.f;
    if (F.wave == 0 && lane < 32) sb[lane] = am * (1.0f / 127.0f);
#pragma unroll
    for (int jb = 0; jb < 2; ++jb) { const int kb = k0 + 64 * jb;
#pragma unroll
        for (int i = 0; i < 32; i += 8) {
            LAS float* sp = scr + (2 * i + (lane >> 5)) * 33 + (lane & 31);
#pragma unroll
            for (int u = 0; u < 8; ++u) sp[2 * u * 33] = a[32 * jb + i + u] * inv; }
        LDS_WAIT(); asm volatile("" ::: "memory");
        const int n = lane >> 1, hf = lane & 1; const LAS float* s = scr + (32 * hf) * 33 + n;
        v4u* o = (v4u*)(dst + (size_t)n * ldd + kb + 32 * hf);
#pragma unroll
        for (int h = 0; h < 2; ++h) { v4u w;
            w.x = pack_i8x4(s[(16 * h + 0) * 33], s[(16 * h + 1) * 33], s[(16 * h + 2) * 33], s[(16 * h + 3) * 33]);
            w.y = pack_i8x4(s[(16 * h + 4) * 33], s[(16 * h + 5) * 33], s[(16 * h + 6) * 33], s[(16 * h + 7) * 33]);
            w.z = pack_i8x4(s[(16 * h + 8) * 33], s[(16 * h + 9) * 33], s[(16 * h + 10) * 33], s[(16 * h + 11) * 33]);
            w.w = pack_i8x4(s[(16 * h + 12) * 33], s[(16 * h + 13) * 33], s[(16 * h + 14) * 33], s[(16 * h + 15) * 33]);
            o[h] = w; asm volatile("" ::: "memory"); }
        LDS_WAIT(); asm volatile("" ::: "memory");
    }
}
__device__ __forceinline__ int inproj_dst_row(int n0) {
    if (n0 >= 3072 && n0 < 5120) { const int tb = n0 & ~255, lc = (n0 >> 5) & 7; return tb + ((lc & 1) * 4 + (lc >> 1)) * 32; }
    return n0;
}
constexpr int MIXW_ITEMS = 1536 + 512 + 128;
__device__ __forceinline__ void conv_mixer_weights(const Frame& F, KArgs ap) {
    LAS float* scr = (LAS float*)(F.lds + RING_OFF + F.wave * 16384);
    const int gw = F.vcu * NWAVES + F.wave, NGW = F.G * NWAVES;
    for (int k = 0;; ++k) { int it;
        if (F.G == 256) { if (k >= (F.bid < 128 ? 1 : 3)) break; it = (k == 0) ? F.bid : 256 + 2 * (F.bid - 128) + (k - 1); }
        else { it = F.bid + k * F.G; if (it >= NLAYER * 256) break; }
        const int l = it >> 8, q = it & 255, n0 = (q < 64 ? q : q + 32) * 32, dr = inproj_dst_row(n0);
        unsigned char* wl = F.ws + WS_W + (size_t)l * W_LAYER;
        quant_cols_i8(F, gin(ap, I_WIN) + (size_t)l * DM * INW, INW, n0, DM, wl + W_IN + (size_t)dr * DM, DM, (float*)(wl + W_SB) + dr); }
    __syncthreads();
    for (int it = gw; it < NLAYER * MIXW_ITEMS; it += NGW) {
        const int l = it / MIXW_ITEMS; int r = it % MIXW_ITEMS;
        unsigned char* wl = F.ws + WS_W + (size_t)l * W_LAYER;
        if (r < 1536) { const int i = r / 512, q = r % 512, kb = q / 32, ch = q % 32;
            transpose_item(gin(ap, I_WBR) + ((size_t)l * 3 + i) * DM * DM, DM, kb * 64, ch * 32, (bf16*)(wl + W_BR) + ((size_t)i * DM + ch * 32) * DM, DM, scr, F.lane); continue; }
        r -= 1536;
        if (r < 512) { const int kb = r / 32, ch = r % 32;
            transpose_item(gin(ap, I_WOUT) + (size_t)l * DM * DM, DM, kb * 64, ch * 32, (bf16*)(wl + W_OUT) + (size_t)(ch * 32) * DM, DM, scr, F.lane); continue; }
        r -= 512;
        { const int which = r / 64, q = r % 64, n = q / 8, kb = (q % 8) / 4, ch = q % 4;
            const float* src = (which ? gin(ap, I_LWX) : gin(ap, I_LWA)) + ((size_t)l * 8 + n) * 128 * 128;
            transpose_item(src, 128, kb * 64, ch * 32, (bf16*)(wl + W_LRU) + ((size_t)n * 256 + which * 128 + ch * 32) * 128, 128, scr, F.lane); }
    }
}
constexpr int MOEW_ITEMS = 4096;
__device__ __forceinline__ void conv_moe_weights(const Frame& F, KArgs ap, int l) {
    LAS float* scr = (LAS float*)(F.lds + RING_OFF + F.wave * 16384);
    const int gw = F.vcu * NWAVES + F.wave, NGW = F.G * NWAVES;
    for (int it = F.bid; it < 512; it += F.G) { const int which = it >> 8, e = (it >> 4) & 15, f0 = (it & 15) * 32;
        const float* src = (which ? gin(ap, I_WU) : gin(ap, I_WG)) + ((size_t)l * NEXP + e) * DM * DEXP;
        const int row = e * 1024 + (f0 >> 7) * 256 + which * 128 + (f0 & 127);
        quant_cols_i8(F, src, DEXP, f0, DM, F.ws + MOE_WGU + (size_t)row * DM, DM, (float*)(F.ws + MOE_SB) + row); }
    __syncthreads();
    for (int it = gw; it < MOEW_ITEMS; it += NGW) { const int e = it / 256, q = it % 256, kb = q / 32, ch = q % 32;
        transpose_item(gin(ap, I_WD) + ((size_t)l * NEXP + e) * DEXP * DM, DM, kb * 64, ch * 32, (bf16*)(F.ws + MOE_WD) + ((size_t)e * 1024 + ch * 32) * DEXP, DEXP, scr, F.lane); }
}
__device__ __forceinline__ void fold_pool_weights(const Frame& F, KArgs ap) {
    LAS float* Wt = (LAS float*)(F.lds + RING_OFF);
    for (int it = F.bid; it < NLAYER * 4 * 16; it += F.G) {
        const int l = it / 64, g = (it / 16) & 3, kb = it & 15;
        const float* win = gin(ap, I_WIN) + (size_t)l * DM * INW + (size_t)(kb * 64) * INW + 2048 + g * 256;
        __syncthreads();
        for (int i = F.tid; i < 64 * 256; i += NWAVES * 64) Wt[i] = win[(size_t)(i >> 8) * INW + (i & 255)];
        __syncthreads();
        const int d = F.tid & 255, kh = F.tid >> 8;
        const float* pw = gin(ap, I_POOLW) + ((size_t)l * 4 + g) * 256 * 256 + d;
        float acc[32];
#pragma unroll
        for (int kk = 0; kk < 32; ++kk) acc[kk] = 0.f;
        for (int c = 0; c < 256; ++c) { const float p = pw[(size_t)c * 256];
#pragma unroll
            for (int kk = 0; kk < 32; ++kk) acc[kk] += Wt[(kh * 32 + kk) * 256 + c] * p; }
        float* dst = (float*)(F.ws + WS_POOLTMP) + ((size_t)l * 1024 + g * 256 + d) * DM + kb * 64 + kh * 32;
#pragma unroll
        for (int q = 0; q < 8; ++q) *(f32x4*)(dst + 4 * q) = (f32x4){acc[4 * q], acc[4 * q + 1], acc[4 * q + 2], acc[4 * q + 3]};
    }
    __syncthreads();
}
__device__ __forceinline__ void quant_pool_cols(const Frame& F) {
    const int gw = F.vcu * NWAVES + F.wave, NGW = F.G * NWAVES;
    for (int it = gw; it < NLAYER * 1024; it += NGW) {
        const int l = it >> 10, n = it & 1023;
        const f32x4* src = (const f32x4*)((const float*)(F.ws + WS_POOLTMP) + (size_t)it * DM) + F.lane;
        f32x4 y[4];
#pragma unroll
        for (int j = 0; j < 4; ++j) y[j] = src[64 * j];
        unsigned char* wl = F.ws + WS_W + (size_t)l * W_LAYER;
        quant_row_store(y, F.lane, wl + W_IN + (size_t)(2048 + n) * DM, (float*)(wl + W_SB) + 2048 + n);
    }
}
__device__ __forceinline__ void ada_mod(const Frame& F, KArgs ap) {
    LAS float* cact = (LAS float*)(F.lds + RING_OFF);
    LAS float* red = cact + 2048;
    __syncthreads();
    for (int i = F.tid; i < NB * DM; i += NWAVES * 64) { const float c = gin(ap, I_C)[i]; cact[i] = c * sigmoidf_(c); }
    __syncthreads();
    for (int it = F.bid; it < NLAYER * 6 * DM / 48; it += F.G) {
        const int j0 = it * 48, l = j0 / (6 * DM), j = (j0 % (6 * DM)) + (F.lane < 48 ? F.lane : 0);
        const float* w = gin(ap, I_WADA) + (size_t)l * DM * 6 * DM + j;
        float s0 = 0.f, s1 = 0.f;
        for (int k = F.wave * 128; k < F.wave * 128 + 128; ++k) { const float wv = w[(size_t)k * 6 * DM]; s0 += cact[k] * wv; s1 += cact[DM + k] * wv; }
        red[(F.wave * 2 + 0) * 64 + F.lane] = s0; red[(F.wave * 2 + 1) * 64 + F.lane] = s1;
        __syncthreads();
        if (F.tid < 96) { const int b = F.tid / 48, jj = F.tid % 48; float s = gin(ap, I_BADA)[(size_t)l * 6 * DM + (j0 % (6 * DM)) + jj];
#pragma unroll
            for (int w8 = 0; w8 < 8; ++w8) s += red[(w8 * 2 + b) * 64 + jj];
            ((float*)(F.ws + WS_MOD))[((size_t)l * NB + b) * 6 * DM + (j0 % (6 * DM)) + jj] = s; }
        __syncthreads();
    }
}
__device__ __forceinline__ void rope_tables(const Frame& F) {
    float* ct = (float*)(F.ws + WS_COS);
    for (int i = F.bid * (NWAVES * 64) + F.tid; i < SEQ * 32; i += F.G * NWAVES * 64) {
        const int pos = i >> 5, d = i & 31;
        const float inv = exp2f(-(float)(2 * d) * (1.0f / 64.0f) * 13.287712379549449f);
        const float ang = (float)pos * inv;
        const double rev = (double)ang * 0.15915494309189535; const float fr = (float)(rev - rint(rev));
        { const int fq = d >> 3, n = (d >> 2) & 1, e = d & 3; const size_t o = (size_t)pos * 64 + n * 16 + fq * 4 + e; ct[o] = __builtin_amdgcn_cosf(fr); ct[o + 32] = __builtin_amdgcn_sinf(fr); }
    }
}

template <bool SRCBF> __device__ __forceinline__ void norm_rows(const Frame& F, const void* src, const float* g, const float* sh, const float* sc, unsigned char* dst, float* xs, int nrows) {
    const int gw = F.vcu * NWAVES + F.wave, NGW = F.G * NWAVES;
    f32x4 mul[4], add[4];
#pragma unroll
    for (int j = 0; j < 4; ++j) { const int c = 4 * F.lane + 256 * j; const f32x4 gv = *(const f32x4*)(g + c), sv = *(const f32x4*)(sc + c); mul[j] = gv * (sv + 1.0f); add[j] = *(const f32x4*)(sh + c); }
    for (int r0 = gw; r0 < nrows; r0 += 4 * NGW) {
        f32x4 v[4][4];
#pragma unroll
        for (int q = 0; q < 4; ++q) { const int r = (r0 + q * NGW < nrows) ? r0 + q * NGW : r0;
            if constexpr (SRCBF) { const v2u* xr = (const v2u*)((const bf16*)src + (size_t)r * DM) + F.lane;
#pragma unroll
                for (int j = 0; j < 4; ++j) { const v2u w = xr[64 * j]; v[q][j] = (f32x4){bflo(w.x), bfhi(w.x), bflo(w.y), bfhi(w.y)}; } }
            else { const f32x4* xr = (const f32x4*)((const float*)src + (size_t)r * DM) + F.lane;
#pragma unroll
                for (int j = 0; j < 4; ++j) v[q][j] = xr[64 * j]; } }
#pragma unroll
        for (int q = 0; q < 4; ++q) { const int r = r0 + q * NGW; if (r < nrows) {
            float s = 0.f;
#pragma unroll
            for (int j = 0; j < 4; ++j) s += (v[q][j].x * v[q][j].x + v[q][j].y * v[q][j].y) + (v[q][j].z * v[q][j].z + v[q][j].w * v[q][j].w);
            const float rs = 1.0f / sqrtf(wave_sum(s, F.lane) * (1.0f / DM) + EPSN);
            f32x4 y[4];
#pragma unroll
            for (int j = 0; j < 4; ++j) y[j] = v[q][j] * rs * mul[j] + add[j];
            quant_row_store(y, F.lane, dst + (size_t)r * DM, xs + r); } }
    }
}
__device__ __forceinline__ void unpack8(const v4u w, float (&x)[8]) { x[0] = bflo(w.x); x[1] = bfhi(w.x); x[2] = bflo(w.y); x[3] = bfhi(w.y); x[4] = bflo(w.z); x[5] = bfhi(w.z); x[6] = bflo(w.w); x[7] = bfhi(w.w); }
__device__ __forceinline__ v4u pack8(const float (&x)[8]) { v4u w; w.x = pk2(x[0], x[1]); w.y = pk2(x[2], x[3]); w.z = pk2(x[4], x[5]); w.w = pk2(x[6], x[7]); return w; }
__device__ __forceinline__ void ld8f(const float* p, float (&x)[8]) { const f32x4 lo = *(const f32x4*)p, hi = *(const f32x4*)(p + 4); x[0] = lo.x; x[1] = lo.y; x[2] = lo.z; x[3] = lo.w; x[4] = hi.x; x[5] = hi.y; x[6] = hi.z; x[7] = hi.w; }
__device__ __forceinline__ void conv_pool_phase(const Frame& F, KArgs ap, int l, unsigned char* slots) {
    const bf16* __restrict__ xl = (const bf16*)(slots + S_XLRU * SLOT); bf16* __restrict__ xc = (bf16*)(slots + S_XC * SLOT);
    const bf16* __restrict__ z = (const bf16*)(slots + S_Z * SLOT); bf16* __restrict__ bp = (bf16*)(slots + S_BRPOOL * SLOT);
    const int gt = F.vcu * (NWAVES * 64) + F.tid, NT = F.G * NWAVES * 64;
    const v4u zero = (v4u){0u, 0u, 0u, 0u};
    for (int it = gt; it < 2 * 65536; it += NT) {
        const int which = it >> 16, r = it & 65535, cg = r & 127, t0 = (r >> 7) * 32, c0 = cg * 8;
        if (which == 0) {
            float w0[8], w1[8], w2[8], w3[8], cb[8], xm3[8], xm2[8], xm1[8];
            ld8f(gin(ap, I_CONVW) + ((size_t)l * 4 + 0) * DM + c0, w0); ld8f(gin(ap, I_CONVW) + ((size_t)l * 4 + 1) * DM + c0, w1);
            ld8f(gin(ap, I_CONVW) + ((size_t)l * 4 + 2) * DM + c0, w2); ld8f(gin(ap, I_CONVW) + ((size_t)l * 4 + 3) * DM + c0, w3);
            ld8f(gin(ap, I_CONVB) + (size_t)l * DM + c0, cb);
            unpack8(t0 >= 3 ? *(const v4u*)(xl + (size_t)(t0 - 3) * DM + c0) : zero, xm3);
            unpack8(t0 >= 2 ? *(const v4u*)(xl + (size_t)(t0 - 2) * DM + c0) : zero, xm2);
            unpack8(t0 >= 1 ? *(const v4u*)(xl + (size_t)(t0 - 1) * DM + c0) : zero, xm1);
            for (int tb = t0; tb < t0 + 32; tb += 8) {
                v4u in[8], ov[8];
#pragma unroll
                for (int u = 0; u < 8; ++u) in[u] = *(const v4u*)(xl + (size_t)(tb + u) * DM + c0);
#pragma unroll
                for (int u = 0; u < 8; ++u) { float x0[8], o[8]; unpack8(in[u], x0);
#pragma unroll
                    for (int i = 0; i < 8; ++i) { o[i] = cb[i] + w0[i] * xm3[i] + w1[i] * xm2[i] + w2[i] * xm1[i] + w3[i] * x0[i]; xm3[i] = xm2[i]; xm2[i] = xm1[i]; xm1[i] = x0[i]; }
                    ov[u] = pack8(o); }
#pragma unroll
                for (int u = 0; u < 8; ++u) *(v4u*)(xc + (size_t)(tb + u) * DM + c0) = ov[u];
            }
        } else {
            const int win = 2 << (cg >> 5);
            float sc[8], sum[8];
            ld8f(gin(ap, I_POOLS) + (size_t)l * DM + c0, sc);
#pragma unroll
            for (int i = 0; i < 8; ++i) sum[i] = 0.f;
            for (int s = (t0 - win > 0 ? t0 - win : 0); s < t0; ++s) { float x[8]; unpack8(*(const v4u*)(z + (size_t)s * DM + c0), x);
#pragma unroll
                for (int i = 0; i < 8; ++i) sum[i] += x[i]; }
            for (int tb = t0; tb < t0 + 32; tb += 8) {
                v4u in[8], old[8], ov[8];
#pragma unroll
                for (int u = 0; u < 8; ++u) { in[u] = *(const v4u*)(z + (size_t)(tb + u) * DM + c0); const int tp = tb + u - win; old[u] = *(const v4u*)(z + (size_t)(tp >= 0 ? tp : 0) * DM + c0); }
#pragma unroll
                for (int u = 0; u < 8; ++u) { float x0[8], xo[8], o[8]; const int t = tb + u; unpack8(in[u], x0); unpack8(t - win >= 0 ? old[u] : zero, xo);
                    const float rc = 1.0f / (float)(t + 1 < win ? t + 1 : win);
#pragma unroll
                    for (int i = 0; i < 8; ++i) { sum[i] += x0[i] - xo[i]; o[i] = (sum[i] * rc - x0[i]) * sc[i]; }
                    ov[u] = pack8(o); }
#pragma unroll
                for (int u = 0; u < 8; ++u) __builtin_nontemporal_store(ov[u], (v4u*)(bp + (size_t)(tb + u) * DM + c0));
            }
        }
    }
}
__device__ __forceinline__ void lru_au(float la, float v, float& a, float& u) {
    a = fexp2(la * LOG2E);
    const float x = 2.0f * la;
    const float om = (x > -0.3f) ? -x * (1.0f + x * 0.5f * (1.0f + x * (1.0f / 3.0f) * (1.0f + x * 0.25f * (1.0f + x * 0.2f)))) : 1.0f - a * a;
    u = sqrtf(om) * v;
}
constexpr int SCH = 64, NCHK = SEQ / SCH;
template <int PASS> __device__ __forceinline__ void scan_phase(const Frame& F, unsigned char* slots) {
    const bf16* __restrict__ la = (const bf16*)(slots + S_LA * SLOT); const bf16* __restrict__ v2 = (const bf16*)(slots + S_V2 * SLOT); bf16* y = (bf16*)(slots + S_Y * SLOT);
    bf16* yo = y;
    float* SA = (float*)(F.ws + WS_SCANA); float* SH = (float*)(F.ws + WS_SCANH);
    if (PASS == 1) {
        const int gt = F.vcu * (NWAVES * 64) + F.tid, NT = F.G * NWAVES * 64;
        for (int it = gt; it < NCHK * 512; it += NT) {
            const int ck = it >> 9, c0 = (it & 511) * 2, t0 = ck * SCH;
            float h0 = 0.f, h1 = 0.f, p0 = 0.f, p1 = 0.f;
            for (int tb = t0; tb < t0 + SCH; tb += 16) {
                unsigned lw[16], vw[16];
#pragma unroll
                for (int u = 0; u < 16; ++u) { lw[u] = *(const unsigned*)(la + (size_t)(tb + u) * DM + c0); vw[u] = *(const unsigned*)(v2 + (size_t)(tb + u) * DM + c0); }
#pragma unroll
                for (int u = 0; u < 16; ++u) {
                    float a0, u0, a1, u1; lru_au(bflo(lw[u]), bflo(vw[u]), a0, u0); lru_au(bfhi(lw[u]), bfhi(vw[u]), a1, u1);
                    h0 = a0 * h0 + u0; h1 = a1 * h1 + u1; p0 += bflo(lw[u]); p1 += bfhi(lw[u]); }
            }
            *(f32x2*)(SA + (size_t)ck * DM + c0) = (f32x2){fexp2(p0 * LOG2E), fexp2(p1 * LOG2E)}; *(f32x2*)(SH + (size_t)ck * DM + c0) = (f32x2){h0, h1};
        }
    } else {
        LAS f32x4* pl = (LAS f32x4*)(F.lds + RING_OFF);
        for (int item = F.vcu; item < NCHK; item += F.G) {
            const int cg = item >> 3, pb = item & 7, c0 = 2 * (64 * pb + F.lane), ck = 8 * cg + F.wave, t0 = ck * SCH;
            float A0 = 1.f, A1 = 1.f, H0 = 0.f, H1 = 0.f; asm volatile("" : "+v"(A0), "+v"(A1));
            for (int j0 = F.wave * cg, je = j0 + cg; j0 < je; j0 += 8) {
                f32x2 A[8], H[8];
#pragma unroll
                for (int u = 0; u < 8; ++u) { const int j = (j0 + u < je) ? j0 + u : je - 1; A[u] = *(const f32x2*)(SA + (size_t)j * DM + c0); H[u] = *(const f32x2*)(SH + (size_t)j * DM + c0); }
#pragma unroll
                for (int u = 0; u < 8; ++u) if (j0 + u < je) { H0 = A[u].x * H0 + H[u].x; H1 = A[u].y * H1 + H[u].y; A0 *= A[u].x; A1 *= A[u].y; }
            }
            f32x2 Ag[7], Hg[7];
#pragma unroll
            for (int u = 0; u < 7; ++u) { Ag[u] = *(const f32x2*)(SA + (size_t)(8 * cg + u) * DM + c0); Hg[u] = *(const f32x2*)(SH + (size_t)(8 * cg + u) * DM + c0); }
            __syncthreads();
            pl[F.wave * 64 + F.lane] = (f32x4){A0, A1, H0, H1};
            __syncthreads();
            float h0 = 0.f, h1 = 0.f;
#pragma unroll
            for (int sg = 0; sg < 8; ++sg) { const f32x4 q = pl[sg * 64 + F.lane]; h0 = q.x * h0 + q.z; h1 = q.y * h1 + q.w; }
#pragma unroll
            for (int u = 0; u < 7; ++u) if (u < F.wave) { h0 = Ag[u].x * h0 + Hg[u].x; h1 = Ag[u].y * h1 + Hg[u].y; }
            for (int tb = t0; tb < t0 + SCH; tb += 16) {
                unsigned lw[16], vw[16], yw[16], ow[16];
#pragma unroll
                for (int u = 0; u < 16; ++u) { lw[u] = *(const unsigned*)(la + (size_t)(tb + u) * DM + c0); vw[u] = *(const unsigned*)(v2 + (size_t)(tb + u) * DM + c0); yw[u] = *(const unsigned*)(y + (size_t)(tb + u) * DM + c0); }
#pragma unroll
                for (int u = 0; u < 16; ++u) {
                    float a0, u0, a1, u1; lru_au(bflo(lw[u]), bflo(vw[u]), a0, u0); lru_au(bfhi(lw[u]), bfhi(vw[u]), a1, u1);
                    h0 = a0 * h0 + u0; h1 = a1 * h1 + u1; ow[u] = pk2(h0 * bflo(yw[u]), h1 * bfhi(yw[u])); }
#pragma unroll
                for (int u = 0; u < 16; ++u) *(unsigned*)(yo + (size_t)(tb + u) * DM + c0) = ow[u];
            }
        }
    }
}

__device__ __forceinline__ void scan_lookback_phase(const Frame& F, unsigned char* slots, const int inst) {
    const bf16* __restrict__ la = (const bf16*)(slots + S_LA * SLOT); const bf16* __restrict__ v2 = (const bf16*)(slots + S_V2 * SLOT); bf16* y = (bf16*)(slots + S_Y * SLOT);
    unsigned* GA = (unsigned*)(F.ws + WS_SCANA) + (size_t)inst * 32 * DM; unsigned* GH = (unsigned*)(F.ws + WS_SCANH) + (size_t)inst * 32 * DM;
    LAS f32x4* pl = (LAS f32x4*)(F.lds + RING_OFF);
    LAS f32x4* pl2 = pl + 512;
    for (int item = F.vcu; item < NCHK; item += F.G) {
        const int cg = item >> 3, pb = item & 7, c0 = 2 * (64 * pb + F.lane), t0 = (8 * cg + F.wave) * SCH;
        float h0 = 0.f, h1 = 0.f, p0 = 0.f, p1 = 0.f;
        for (int tb = t0; tb < t0 + SCH; tb += 16) {
            unsigned lw[16], vw[16];
#pragma unroll
            for (int u = 0; u < 16; ++u) { lw[u] = *(const unsigned*)(la + (size_t)(tb + u) * DM + c0); vw[u] = *(const unsigned*)(v2 + (size_t)(tb + u) * DM + c0); }
#pragma unroll
            for (int u = 0; u < 16; ++u) { float a0, u0, a1, u1; lru_au(bflo(lw[u]), bflo(vw[u]), a0, u0); lru_au(bfhi(lw[u]), bfhi(vw[u]), a1, u1);
                h0 = a0 * h0 + u0; h1 = a1 * h1 + u1; p0 += bflo(lw[u]); p1 += bfhi(lw[u]); }
        }
        __syncthreads();
        pl[F.wave * 64 + F.lane] = (f32x4){fexp2(p0 * LOG2E), fexp2(p1 * LOG2E), h0, h1};
        __syncthreads();
        if (F.wave == 0) { float A0 = 1.f, A1 = 1.f, H0 = 0.f, H1 = 0.f; asm volatile("" : "+v"(A0), "+v"(A1));
#pragma unroll
            for (int sg = 0; sg < 8; ++sg) { const f32x4 q = pl[sg * 64 + F.lane]; H0 = q.x * H0 + q.z; H1 = q.y * H1 + q.w; A0 *= q.x; A1 *= q.y; }
            __hip_atomic_store(GA + (size_t)cg * DM + c0, __float_as_uint(A0), __ATOMIC_RELAXED, __HIP_MEMORY_SCOPE_AGENT); __hip_atomic_store(GA + (size_t)cg * DM + c0 + 1, __float_as_uint(A1), __ATOMIC_RELAXED, __HIP_MEMORY_SCOPE_AGENT);
            __hip_atomic_store(GH + (size_t)cg * DM + c0, __float_as_uint(H0), __ATOMIC_RELAXED, __HIP_MEMORY_SCOPE_AGENT); __hip_atomic_store(GH + (size_t)cg * DM + c0 + 1, __float_as_uint(H1), __ATOMIC_RELAXED, __HIP_MEMORY_SCOPE_AGENT); }
        asm volatile("s_waitcnt vmcnt(0)" ::: "memory");
        __syncthreads();
        gu32* fl = F.ctl + CW_SCANF + (size_t)inst * 4096;
        if (F.wave == 0) {
            if (F.lane == 0) { __builtin_amdgcn_fence(__ATOMIC_RELEASE, "agent"); asm volatile("s_waitcnt vmcnt(0)" ::: "memory");
                (void)xb_add((unsigned*)(fl + item * 16), 1u); }
            unsigned sp = 0;
            for (;;) { const unsigned ok = (F.lane < cg) ? xb_ld((unsigned*)(fl + (F.lane * 8 + pb) * 16)) : 1u;
                if (__builtin_amdgcn_ballot_w64(ok == 0u) == 0ull) break;
                __builtin_amdgcn_s_sleep(1);
                if ((++sp & 255u) == 0u) { unsigned* bar = (unsigned*)(F.ctl + CW_BAR); if (xb_ld(&bar[XB_TMO])) break; if (sp > XB_SPIN_CAP) { if (F.lane == 0) atomicAdd(&bar[XB_TMO], 1u); break; } } }
            if (F.lane == 0) { __builtin_amdgcn_fence(__ATOMIC_ACQUIRE, "agent"); asm volatile("s_waitcnt vmcnt(0)" ::: "memory"); }
        }
        __syncthreads();
        { const int cgs = (cg + 7) >> 3, j0 = F.wave * cgs, j1 = (j0 + cgs < cg) ? j0 + cgs : cg;
          float A0 = 1.f, A1 = 1.f, H0 = 0.f, H1 = 0.f; asm volatile("" : "+v"(A0), "+v"(A1));
          unsigned ga[4][2], gh[4][2];
#pragma unroll
          for (int k = 0; k < 4; ++k) { const int j = (j0 + k < j1) ? j0 + k : (j1 > 0 ? j1 - 1 : 0);
              ga[k][0] = __hip_atomic_load(GA + (size_t)j * DM + c0, __ATOMIC_RELAXED, __HIP_MEMORY_SCOPE_AGENT); ga[k][1] = __hip_atomic_load(GA + (size_t)j * DM + c0 + 1, __ATOMIC_RELAXED, __HIP_MEMORY_SCOPE_AGENT);
              gh[k][0] = __hip_atomic_load(GH + (size_t)j * DM + c0, __ATOMIC_RELAXED, __HIP_MEMORY_SCOPE_AGENT); gh[k][1] = __hip_atomic_load(GH + (size_t)j * DM + c0 + 1, __ATOMIC_RELAXED, __HIP_MEMORY_SCOPE_AGENT); }
#pragma unroll
          for (int k = 0; k < 4; ++k) if (j0 + k < j1) { const float a0 = __uint_as_float(ga[k][0]), a1 = __uint_as_float(ga[k][1]);
              H0 = a0 * H0 + __uint_as_float(gh[k][0]); H1 = a1 * H1 + __uint_as_float(gh[k][1]); A0 *= a0; A1 *= a1; }
          pl2[F.wave * 64 + F.lane] = (f32x4){A0, A1, H0, H1}; }
        __syncthreads();
        h0 = 0.f; h1 = 0.f;
#pragma unroll
        for (int sg = 0; sg < 8; ++sg) { const f32x4 q = pl2[sg * 64 + F.lane]; h0 = q.x * h0 + q.z; h1 = q.y * h1 + q.w; }
#pragma unroll
        for (int sg = 0; sg < 7; ++sg) if (sg < F.wave) { const f32x4 q = pl[sg * 64 + F.lane]; h0 = q.x * h0 + q.z; h1 = q.y * h1 + q.w; }
        for (int tb = t0; tb < t0 + SCH; tb += 16) {
            unsigned lw[16], vw[16], yw[16], ow[16];
#pragma unroll
            for (int u = 0; u < 16; ++u) { lw[u] = *(const unsigned*)(la + (size_t)(tb + u) * DM + c0); vw[u] = *(const unsigned*)(v2 + (size_t)(tb + u) * DM + c0); yw[u] = *(const unsigned*)(y + (size_t)(tb + u) * DM + c0); }
#pragma unroll
            for (int u = 0; u < 16; ++u) { float a0, u0, a1, u1; lru_au(bflo(lw[u]), bflo(vw[u]), a0, u0); lru_au(bfhi(lw[u]), bfhi(vw[u]), a1, u1);
                h0 = a0 * h0 + u0; h1 = a1 * h1 + u1; ow[u] = pk2(h0 * bflo(yw[u]), h1 * bfhi(yw[u])); }
#pragma unroll
            for (int u = 0; u < 16; ++u) __builtin_nontemporal_store(ow[u], (unsigned*)(y + (size_t)(tb + u) * DM + c0));
        }
    }
}

using pg8::GUnit;
typedef const pg8::f32x4 (&AccRef)[2][2][4][2];
__device__ __forceinline__ v4u pack_f4(const f32x4 a, const f32x4 b) { v4u w; w.x = pk2(a.x, a.y); w.y = pk2(a.z, a.w); w.z = pk2(b.x, b.y); w.w = pk2(b.z, b.w); return w; }
template <int ACT> __device__ __forceinline__ float actf(float v) { return ACT == 1 ? gelu_tanh(v) : (ACT == 2 ? sigmoidf_(v) : v); }
template <int ACT> __device__ __forceinline__ f32x4 act4(const f32x4 v) { f32x4 r = (f32x4){actf<ACT>(v.x), actf<ACT>(v.y), actf<ACT>(v.z), actf<ACT>(v.w)};
    if (ACT == 2) asm volatile("s_nop 1" : "+v"(r));
    return r; }
template <int ACT> __device__ __forceinline__ void store_tile_bf16(AccRef acc, bf16* base, int ld, int row0, int col0) {
#pragma unroll
    for (int ai = 0; ai < 2; ++ai)
#pragma unroll
        for (int m = 0; m < 4; ++m) { const unsigned ob = ((unsigned)(row0 + ai * 128 + m * 16) * (unsigned)ld + (unsigned)col0) * 2u;
#pragma unroll
            for (int bj = 0; bj < 2; ++bj) *(v4u*)((char*)base + ob + bj * 256) = pack_f4(act4<ACT>(acc[ai][bj][m][0]), act4<ACT>(acc[ai][bj][m][1])); }
}
template <int ACT> __device__ __forceinline__ void store_tile_acc(AccRef acc, char* base, unsigned soff) {
    unsigned sbj = 8192u; asm volatile("" : "+s"(sbj)); const unsigned sm = sbj * 2u, sai = sbj * 8u;
#pragma unroll
    for (int ai = 0; ai < 2; ++ai)
#pragma unroll
        for (int m = 0; m < 4; ++m) { const unsigned ob = soff + (unsigned)ai * sai + (unsigned)m * sm;
#pragma unroll
            for (int bj = 0; bj < 2; ++bj) __builtin_nontemporal_store(pack_f4(act4<ACT>(acc[ai][bj][m][0]), act4<ACT>(acc[ai][bj][m][1])), (v4u*)(base + ob + (unsigned)bj * sbj)); }
}
#ifndef MOE1_PRE
#define MOE1_PRE 0
#endif
#ifndef EPI_OUT_PRE
#define EPI_OUT_PRE 1
#endif
#ifndef EPI_PRE
#define EPI_PRE 1
#endif
struct EpiInProj {
    static constexpr bool PERM = true; static constexpr bool I8 = true; static constexpr int NSTORE = EPI_PRE ? 16 : 0;
    unsigned char* slots; const float* qn_g; const float* kn_g; const float* cosT; const float* sinT; const float* sa; const float* sb;
    __device__ __forceinline__ const float* sa_ptr(const GUnit& u) const { return sa + u.pm * 256; }
    __device__ __forceinline__ const float* sb_ptr(const GUnit& u) const { return sb + u.pn * 256; }
    __device__ __forceinline__ void operator()(AccRef acc, const GUnit& u, int wr, int wc, int fr, int fq) const {
        const int sec = u.pn >> 2, tcol = (u.pn & 3) * 256, row0 = u.pm * 256 + wr * 64 + fr, col0 = tcol + wc * 32 + 8 * fq;
        if (sec == 3 || sec == 4) {
            const float* gn = (sec == 3) ? qn_g : kn_g; const float osc = (sec == 3) ? attn128::C2 : 1.0f;
            bf16* base = (bf16*)(slots + (size_t)(sec == 3 ? S_Q : S_K) * SLOT); const int colq = tcol + wc * 64 + 8 * fq;
            f32x4 gA[2], gB[2];
#pragma unroll
            for (int n = 0; n < 2; ++n) { gA[n] = *(const f32x4*)(gn + 8 * fq + 4 * n) * osc; gB[n] = *(const f32x4*)(gn + 32 + 8 * fq + 4 * n) * osc; }
            f32x4 Ct[2][2], St[2][2];
#define QK_LOAD(g, buf) do { const int row_ = row0 + ((g) >> 2) * 128 + ((g) & 3) * 16; _Pragma("unroll") for (int n = 0; n < 2; ++n) { const unsigned tb = ((unsigned)row_ * 64u + 16u * n + 4u * fq) * 4u; \
                Ct[buf][n] = *(const f32x4*)((const char*)cosT + tb); St[buf][n] = *(const f32x4*)((const char*)cosT + tb + 128u); } } while (0)
            QK_LOAD(0, 0);
#pragma unroll
            for (int g = 0; g < 8; ++g) { const int ai = g >> 2, m = g & 3, row = row0 + ai * 128 + m * 16;
                if (g < 7) QK_LOAD(g + 1, (g + 1) & 1);
                float ss = 0.f;
#pragma unroll
                for (int bj = 0; bj < 2; ++bj)
#pragma unroll
                    for (int n = 0; n < 2; ++n) { const f32x4 x = acc[ai][bj][m][n]; ss += (x.x * x.x + x.y * x.y) + (x.z * x.z + x.w * x.w); }
                { const int ln = fq * 16 + fr; ss += shx(ss, ln, 16); ss += shx(ss, ln, 32); }
                const float rs = 1.0f / sqrtf(ss * (1.0f / 64.0f) + EPSN);
                f32x4 o1[2], o2[2];
#pragma unroll
                for (int n = 0; n < 2; ++n) { const f32x4 c = Ct[g & 1][n], sn = St[g & 1][n];
                    const f32x4 x1 = acc[ai][0][m][n] * rs * gA[n], x2 = acc[ai][1][m][n] * rs * gB[n];
                    o1[n] = x1 * c - x2 * sn; o2[n] = x2 * c + x1 * sn; }
                const unsigned ob = ((unsigned)row * DM + (unsigned)colq) * 2u;
                *(v4u*)((char*)base + ob) = pack_f4(o1[0], o1[1]); *(v4u*)((char*)base + ob + 64) = pack_f4(o2[0], o2[1]); }
#undef QK_LOAD
        } else if (sec == 1) { store_tile_bf16<1>(acc, (bf16*)(slots + (size_t)S_Y * SLOT), DM, row0, col0); }
        else if (sec >= 6) { store_tile_acc<2>(acc, (char*)(slots + (size_t)(S_G0 + sec - 6) * SLOT), (unsigned)(u.pm * 4 + (u.pn & 3)) * 131072u + (unsigned)((wr * 4 + wc) * 64 + fq * 16 + fr) * 16u); }
        else { const int sl = (sec == 0) ? S_XLRU : (sec == 2 ? S_Z : S_V); store_tile_bf16<0>(acc, (bf16*)(slots + (size_t)sl * SLOT), DM, row0, col0); }
    }
};
__device__ __forceinline__ float logsigmoid8(float L) {
    const float e = __expf(-fabsf(L));
    const float l1p = (e < 0.1f) ? e * (1.0f - e * (0.5f - e * ((1.0f / 3.0f) - e * 0.25f))) : __logf(1.0f + e);
    return 8.0f * (fminf(L, 0.0f) - l1p);
}
struct EpiLruGates {
    static constexpr bool PERM = true; static constexpr bool I8 = false; static constexpr int NSTORE = EPI_PRE ? 16 : 0;
    unsigned char* slots; const float* ba; const float* bx; const float* ll;
    __device__ __forceinline__ void operator()(AccRef acc, const GUnit& u, int wr, int wc, int fr, int fq) const {
        const int ch0 = u.pn * 128 + wc * 32 + 8 * fq, row0 = u.pm * 256 + wr * 64 + fr;
        const bf16* xc = (const bf16*)(slots + (size_t)S_XC * SLOT); bf16* la = (bf16*)(slots + (size_t)S_LA * SLOT); bf16* v2 = (bf16*)(slots + (size_t)S_V2 * SLOT);
        f32x4 Lc[2], bav[2], bxv[2];
#pragma unroll
        for (int n = 0; n < 2; ++n) { const f32x4 lv = *(const f32x4*)(ll + ch0 + 4 * n); Lc[n] = (f32x4){logsigmoid8(lv.x), logsigmoid8(lv.y), logsigmoid8(lv.z), logsigmoid8(lv.w)};
            bav[n] = *(const f32x4*)(ba + ch0 + 4 * n); bxv[n] = *(const f32x4*)(bx + ch0 + 4 * n); }
        v4u xw8[8];
#pragma unroll
        for (int g = 0; g < 8; ++g) xw8[g] = *(const v4u*)((const char*)xc + ((unsigned)(row0 + (g >> 2) * 128 + (g & 3) * 16) * DM + (unsigned)ch0) * 2u);
#pragma unroll
        for (int ai = 0; ai < 2; ++ai)
#pragma unroll
            for (int m = 0; m < 4; ++m) { const unsigned off = ((unsigned)(row0 + ai * 128 + m * 16) * DM + (unsigned)ch0) * 2u;
                const v4u xw = xw8[ai * 4 + m];
                const f32x4 x0 = (f32x4){bflo(xw.x), bfhi(xw.x), bflo(xw.y), bfhi(xw.y)}, x1 = (f32x4){bflo(xw.z), bfhi(xw.z), bflo(xw.w), bfhi(xw.w)};
                const f32x4 a0 = act4<2>(acc[ai][0][m][0] + bav[0]) * Lc[0], a1 = act4<2>(acc[ai][0][m][1] + bav[1]) * Lc[1];
                const f32x4 g0 = act4<2>(acc[ai][1][m][0] + bxv[0]) * x0, g1 = act4<2>(acc[ai][1][m][1] + bxv[1]) * x1;
                *(v4u*)((char*)la + off) = pack_f4(a0, a1); *(v4u*)((char*)v2 + off) = pack_f4(g0, g1); }
    }
};
struct EpiMerge {
    static constexpr bool PERM = true; static constexpr bool I8 = false; static constexpr int NSTORE = EPI_PRE ? 16 : 0;
    unsigned char* slots; unsigned wgoff;
    template <bool PREV, bool LAST> __device__ __forceinline__ void run(AccRef acc, const bf16* gate, bf16* mg, unsigned offb, char* scr, unsigned soff, unsigned goff) const {
        v4u G[2][4], Q[2][4]; unsigned gs_ = 8192u; asm volatile("" : "+s"(gs_));
#define MG_OFF(g) (offb + (unsigned)((((g) >> 3) * 128 + (((g) >> 1) & 3) * 16) * DM + ((g) & 1) * 128) * 2u)
#define MG_SOFF(g) (soff + (unsigned)(g) * 1024u)
#define MG_GOFF(g) (goff + (unsigned)(g) * gs_)
#define MG_LOAD(b, buf) do { _Pragma("unroll") for (int k = 0; k < 4; ++k) { G[buf][k] = *(const v4u*)((const char*)gate + MG_GOFF(4 * (b) + k)); \
            if (PREV) Q[buf][k] = __builtin_nontemporal_load((const v4u*)(scr + MG_SOFF(4 * (b) + k))); } } while (0)
        MG_LOAD(0, 0);
#pragma unroll
        for (int b = 0; b < 4; ++b) {
            if (b < 3) MG_LOAD(b + 1, (b + 1) & 1);
#pragma unroll
            for (int k = 0; k < 4; ++k) { const int g = 4 * b + k, ai = g >> 3, m = (g >> 1) & 3, bj = g & 1; const v4u gw = G[b & 1][k];
                f32x4 o0 = (f32x4){bflo(gw.x), bfhi(gw.x), bflo(gw.y), bfhi(gw.y)} * acc[ai][bj][m][0], o1 = (f32x4){bflo(gw.z), bfhi(gw.z), bflo(gw.w), bfhi(gw.w)} * acc[ai][bj][m][1];
                if (PREV) { const v4u pw = Q[b & 1][k]; o0 += (f32x4){bflo(pw.x), bfhi(pw.x), bflo(pw.y), bfhi(pw.y)}; o1 += (f32x4){bflo(pw.z), bfhi(pw.z), bflo(pw.w), bfhi(pw.w)}; }
                if (LAST) *(v4u*)((char*)mg + MG_OFF(g)) = pack_f4(o0, o1); else *(v4u*)(scr + MG_SOFF(g)) = pack_f4(o0, o1); }
        }
#undef MG_LOAD
#undef MG_SOFF
#undef MG_GOFF
#undef MG_OFF
    }
    __device__ __forceinline__ void operator()(AccRef acc, const GUnit& u, int wr, int wc, int fr, int fq) const {
        const int row0 = u.pm * 256 + wr * 64 + fr, col0 = u.pn * 256 + wc * 32 + 8 * fq; const int i = u.aux;
        const bf16* gate = (const bf16*)(slots + (size_t)(S_G0 + i) * SLOT); bf16* mg = (bf16*)(slots + (size_t)S_MERGED * SLOT);
        char* scr = (char*)(slots + (size_t)S_XLRU * SLOT) + wgoff;
        const unsigned offb = ((unsigned)row0 * DM + (unsigned)col0) * 2u, soff = (unsigned)(((wr * 4 + wc) * 16) * 64 + fq * 16 + fr) * 16u;
        const unsigned goff = (unsigned)(u.pm * 4 + u.pn) * 131072u + (unsigned)((wr * 4 + wc) * 64 + fq * 16 + fr) * 16u;
        if (i == 0) run<false, false>(acc, gate, mg, offb, scr, soff, goff); else if (i == 1) run<true, false>(acc, gate, mg, offb, scr, soff, goff); else run<true, true>(acc, gate, mg, offb, scr, soff, goff);
    }
};
struct EpiOut {
    static constexpr bool PERM = true; static constexpr bool I8 = false; static constexpr int NSTORE = EPI_OUT_PRE ? 16 : 0;
    const void* xsrc; bf16* xb; const float* g1; int rowoff; bool srcf32;
    template <bool F32> __device__ __forceinline__ void run(AccRef acc, unsigned e0, const f32x4 (&gv)[2][2]) const {
        v4u X[2][4], Y[2][4];
#define XO_E(g) (e0 + (unsigned)((((g) >> 3) * 128 + (((g) >> 1) & 3) * 16) * DM + ((g) & 1) * 128))
#define XO_LOAD(b, buf) do { _Pragma("unroll") for (int k = 0; k < 4; ++k) { const unsigned e_ = XO_E(4 * (b) + k); \
            if (F32) { X[buf][k] = *(const v4u*)((const char*)xsrc + e_ * 4u); Y[buf][k] = *(const v4u*)((const char*)xsrc + e_ * 4u + 16); } else X[buf][k] = *(const v4u*)((const char*)xsrc + e_ * 2u); } } while (0)
        XO_LOAD(0, 0);
#pragma unroll
        for (int b = 0; b < 4; ++b) {
            if (b < 3) XO_LOAD(b + 1, (b + 1) & 1);
#pragma unroll
            for (int k = 0; k < 4; ++k) { const int g = 4 * b + k, ai = g >> 3, m = (g >> 1) & 3, bj = g & 1; const v4u w = X[b & 1][k];
                f32x4 x0, x1;
                if (F32) { x0 = __builtin_bit_cast(f32x4, w); x1 = __builtin_bit_cast(f32x4, Y[b & 1][k]); }
                else { x0 = (f32x4){bflo(w.x), bfhi(w.x), bflo(w.y), bfhi(w.y)}; x1 = (f32x4){bflo(w.z), bfhi(w.z), bflo(w.w), bfhi(w.w)}; }
                const f32x4 o0 = x0 + gv[bj][0] * acc[ai][bj][m][0], o1 = x1 + gv[bj][1] * acc[ai][bj][m][1];
                if (rowoff == 0) __builtin_nontemporal_store(pack_f4(o0, o1), (v4u*)((char*)xb + XO_E(g) * 2u)); else *(v4u*)((char*)xb + XO_E(g) * 2u) = pack_f4(o0, o1); }
        }
#undef XO_LOAD
#undef XO_E
    }
    __device__ __forceinline__ void operator()(AccRef acc, const GUnit& u, int wr, int wc, int fr, int fq) const {
        const int row0 = rowoff + u.pm * 256 + wr * 64 + fr, col0 = u.pn * 256 + wc * 32 + 8 * fq;
        f32x4 gv[2][2];
#pragma unroll
        for (int bj = 0; bj < 2; ++bj) { gv[bj][0] = *(const f32x4*)(g1 + col0 + bj * 128); gv[bj][1] = *(const f32x4*)(g1 + col0 + bj * 128 + 4); }
        const unsigned e0 = (unsigned)row0 * DM + (unsigned)col0;
        if (srcf32) run<true>(acc, e0, gv); else run<false>(acc, e0, gv);
    }
};
struct EpiMoe1 {
    static constexpr bool PERM = true; static constexpr bool I8 = true; static constexpr int NSTORE = MOE1_PRE ? 8 : 0;
    bf16* act; const float* wtab; const float* stab; const float* sbm;
    __device__ __forceinline__ const float* sa_ptr(const GUnit& u) const { return stab + (size_t)u.aux * NTOK + u.aux2 * 256; }
    __device__ __forceinline__ const float* sb_ptr(const GUnit& u) const { return sbm + u.aux * 1024 + u.pn * 256; }
    __device__ __forceinline__ void operator()(AccRef acc, const GUnit& u, int wr, int wc, int fr, int fq) const {
        const int row0 = u.pm * 256 + wr * 64 + fr, col0 = u.pn * 128 + wc * 32 + 8 * fq;
#ifndef MOE1_SERIAL
        float w8[8];
#pragma unroll
        for (int g = 0; g < 8; ++g) w8[g] = *(const float*)((const char*)wtab + ((unsigned)u.aux * NTOK + (unsigned)(u.aux2 * 256 + (wr * 64 + fr + (g >> 2) * 128 + (g & 3) * 16))) * 4u);
#endif
#pragma unroll
        for (int ai = 0; ai < 2; ++ai)
#pragma unroll
#ifdef MOE1_SERIAL
            for (int m = 0; m < 4; ++m) { const int row = row0 + ai * 128 + m * 16; const float w = *(const float*)((const char*)wtab + ((unsigned)u.aux * NTOK + (unsigned)(u.aux2 * 256 + (row - u.pm * 256))) * 4u);
#else
            for (int m = 0; m < 4; ++m) { const int row = row0 + ai * 128 + m * 16; const float w = w8[ai * 4 + m];
#endif
                const f32x4 g0 = acc[ai][0][m][0], g1 = acc[ai][0][m][1];
                const f32x4 o0 = g0 * act4<2>(g0) * acc[ai][1][m][0] * w, o1 = g1 * act4<2>(g1) * acc[ai][1][m][1] * w;
                *(v4u*)((char*)act + ((unsigned)row * DEXP + (unsigned)col0) * 2u) = pack_f4(o0, o1); }
    }
};
struct EpiMoe2 {
    static constexpr bool PERM = true; static constexpr bool I8 = false; static constexpr int NSTORE = EPI_PRE ? 16 : 0;
    bf16* y;
    __device__ __forceinline__ void operator()(AccRef acc, const GUnit& u, int wr, int wc, int fr, int fq) const {
        store_tile_bf16<0>(acc, y, DM, u.pm * 256 + wr * 64 + fr, u.pn * 256 + wc * 32 + 8 * fq);
    }
};
struct SchedTiles { static constexpr bool GATHER = false;
    const char* A; const char* B; size_t astep, bstep, acol; int nM, nN, G, c;
    __device__ __forceinline__ bool next(int i, GUnit& u) const { int pm, pn; if (!pg8::static_tile(i, G, c, nM, nN, pm, pn)) return false;
        u.pm = pm; u.pn = pn; u.aux = 0; u.A = A + (size_t)pm * astep + (size_t)pn * acol; u.B = B + (size_t)pn * bstep; return true; }
};
struct SchedMerge { static constexpr bool GATHER = false;
    unsigned char* slots; const char* B; int G, c;
    __device__ __forceinline__ bool next(int j, GUnit& u) const { int pm, pn; const int r = j / 3, i = j - 3 * r; if (!pg8::static_tile(r, G, c, SEQ / 256, DM / 256, pm, pn)) return false;
        const int sl = (i == 0) ? S_Y : (i == 1 ? S_BRPOOL : S_O0);
        u.pm = pm; u.pn = pn; u.aux = i; u.A = (const char*)slots + (size_t)sl * SLOT + (size_t)pm * 256 * DM * 2; u.B = B + ((size_t)i * DM + pn * 256) * DM * 2; return true; }
};
template <bool GATHER_> struct SchedMoe { static constexpr bool GATHER = GATHER_;
    const char* A; const char* B; size_t astep, bstep_e, bstep_n; const LAS int* tcum; const int* inv; int G, c, tid;
    __device__ __forceinline__ bool next(int i, GUnit& u) const {
        const int ntile = __builtin_amdgcn_readfirstlane(tcum[16]), nwg = ntile * 4; const long L = (long)i * G + c; if (L >= nwg) return false;
        int id = (int)L; { const int q = nwg / 8, r = nwg % 8, xcd = id % 8, off = id / 8; id = (xcd < r ? xcd * (q + 1) : r * (q + 1) + (xcd - r) * q) + off; }
        const int rt = id >> 2, tn = id & 3; int e = 0;
#pragma unroll
        for (int k = 1; k < 16; ++k) e += (rt >= __builtin_amdgcn_readfirstlane(tcum[k])) ? 1 : 0;
        const int tm = rt - __builtin_amdgcn_readfirstlane(tcum[e]);
        u.pm = rt; u.pn = tn; u.aux = e; u.aux2 = tm; u.B = B + (size_t)e * bstep_e + (size_t)tn * bstep_n;
        if constexpr (GATHER) {
            u.A = A; const int cnt = __builtin_amdgcn_readfirstlane(tcum[32 + e]);
#pragma unroll
            for (int q = 0; q < 2; ++q) { int R, C; pg8::stage_rc(tid * 16 + q * 8192, R, C);
                const int p0 = tm * 256 + R, p1 = p0 + 128;
                const unsigned ib = ((unsigned)e * NTOK + (unsigned)p0) * 4u;
                const int t0 = *(const int*)((const char*)inv + (p0 < cnt ? ib : (unsigned)e * NTOK * 4u)), t1 = *(const int*)((const char*)inv + (p1 < cnt ? ib + 512u : (unsigned)e * NTOK * 4u));
                u.va0[q] = (unsigned)(t0 * DM + C * 2); u.va1[q] = (unsigned)(t1 * DM + C * 2); }
        } else u.A = A + (size_t)rt * astep;
        return true; }
};

__device__ __forceinline__ void moe_table(const Frame& F, int l) {
    LAS int* tcum = (LAS int*)(F.lds + LDSCTL_OFF);
    __syncthreads();
    if (F.tid == 0) { int cum = 0;
        for (int e = 0; e < NEXP; ++e) { const int c = (int)__hip_atomic_load((unsigned*)(F.ctl + CW_EXPCNT + (l * 16 + e) * 64), RLX_AGENT); tcum[e] = cum; tcum[32 + e] = c; cum += (c + 255) >> 8; }
        tcum[16] = cum; }
    __syncthreads();
}
__device__ __forceinline__ float sel4(int i, float a, float b, float c, float d) { return i == 0 ? a : (i == 1 ? b : (i == 2 ? c : d)); }
__device__ __forceinline__ void router_phase(const Frame& F, KArgs ap, int l) {
    LAS float* rwT = (LAS float*)(F.lds + RING_OFF);
    LAS int* wcnt = (LAS int*)(F.lds + RING_OFF + 65536);
    LAS int* wbase = wcnt + 128;
    __syncthreads();
    for (int i = F.tid; i < DM * NEXP; i += NWAVES * 64) rwT[(i & 15) * DM + (i >> 4)] = gin(ap, I_RW)[i];
    __syncthreads();
    const float* mod = (const float*)(F.ws + WS_MOD); const bf16* xin = (const bf16*)(F.ws + WS_XB); unsigned char* xn = F.ws + MOE_XN; float* xsa = (float*)(F.ws + WS_XSA); float* stab = (float*)(F.ws + WS_STAB);
    float rb[16];
#pragma unroll
    for (int e = 0; e < 16; ++e) rb[e] = gin(ap, I_RB)[e];
    int2* tok_e = (int2*)(F.ws + WS_TOKE); int2* tok_p = (int2*)(F.ws + WS_TOKP); int* inv = (int*)(F.ws + WS_INV); float* wtab = (float*)(F.ws + WS_WTAB);
    int elane[16];
    { float tg[16];
#pragma unroll
      for (int e = 0; e < 16; ++e) { tg[e] = (float)e; asm volatile("" : "+v"(tg[e])); }
      const int mine = (int)(red16(tg) * (1.0f / 64.0f) + 0.5f);
#pragma unroll
      for (int e = 0; e < 16; ++e) { const unsigned long long m = __ballot(mine == e); elane[e] = (int)__builtin_ctzll(m | (1ull << 63)); } }
    for (int blk = F.bid; blk < NTOK / 128; blk += F.G) {
        const int rbase = blk * 128 + F.wave * 16, b = (blk * 128) / SEQ;
        const float* sh = mod + ((size_t)l * NB + b) * 6 * DM + 3 * DM; const float* sc = sh + DM; const float* g = gin(ap, I_N2G) + (size_t)l * DM;
        f32x4 mul[4], add[4];
#pragma unroll
        for (int j = 0; j < 4; ++j) { const int c = 4 * F.lane + 256 * j; mul[j] = *(const f32x4*)(g + c) * (*(const f32x4*)(sc + c) + 1.0f); add[j] = *(const f32x4*)(sh + c); }
        int cnt = 0, me0 = 0, me1 = 0, ml0 = 0, ml1 = 0; float mw0 = 0.f, mw1 = 0.f, msc = 0.f;
        v2u nv[4];
        { const v2u* xr = (const v2u*)(xin + (size_t)rbase * DM) + F.lane;
#pragma unroll
          for (int j = 0; j < 4; ++j) nv[j] = xr[64 * j]; }
#pragma nounroll
        for (int r = 0; r < 16; ++r) {
            const int row = rbase + r;
            f32x4 v[4]; float s = 0.f;
#pragma unroll
            for (int j = 0; j < 4; ++j) { v[j] = (f32x4){bflo(nv[j].x), bfhi(nv[j].x), bflo(nv[j].y), bfhi(nv[j].y)}; s += (v[j].x * v[j].x + v[j].y * v[j].y) + (v[j].z * v[j].z + v[j].w * v[j].w); }
            { const v2u* xr = (const v2u*)(xin + (size_t)(r < 15 ? row + 1 : row) * DM) + F.lane;
#pragma unroll
              for (int j = 0; j < 4; ++j) nv[j] = xr[64 * j]; }
            const float rs = 1.0f / sqrtf(wave_sum(s, F.lane) * (1.0f / DM) + EPSN);
#pragma unroll
            for (int j = 0; j < 4; ++j) v[j] = v[j] * rs * mul[j] + add[j];
            const float rsc = quant_row_store(v, F.lane, xn + (size_t)row * DM, xsa + row);
            float lg[16], tp[16];
#pragma unroll
            for (int e = 0; e < 16; ++e) { float t = 0.f;
#pragma unroll
                for (int j = 0; j < 4; ++j) { const f32x4 w4 = *(const LAS f32x4*)(rwT + e * DM + 256 * j + 4 * F.lane); t += (v[j].x * w4.x + v[j].y * w4.y) + (v[j].z * w4.z + v[j].w * w4.w); }
                tp[e] = t; asm volatile("" ::: "memory"); }
            { const float tot = red16(tp);
#pragma unroll
              for (int e = 0; e < 16; ++e) lg[e] = __uint_as_float((unsigned)__builtin_amdgcn_readlane((int)__float_as_uint(tot), elane[e])); }
            float best = -INFINITY, A0 = 0.f, A1 = 0.f; int e0 = 0, e1 = 1;
#pragma unroll
            for (int gI = 0; gI < 4; ++gI) {
                float af[4], sl[4];
#pragma unroll
                for (int k = 0; k < 4; ++k) { af[k] = 1.0f / (1.0f + __expf(-lg[4 * gI + k])); sl[k] = af[k] + rb[4 * gI + k]; }
                int i1 = 0; float m1 = sl[0];
#pragma unroll
                for (int k = 1; k < 4; ++k) if (sl[k] > m1) { m1 = sl[k]; i1 = k; }
                int i2 = 0; float m2 = -INFINITY;
#pragma unroll
                for (int k = 0; k < 4; ++k) if (k != i1 && sl[k] > m2) { m2 = sl[k]; i2 = k; }
                const float gs = m1 + m2;
                if (gs > best) { best = gs; e0 = 4 * gI + i1; e1 = 4 * gI + i2; A0 = sel4(i1, af[0], af[1], af[2], af[3]); A1 = sel4(i2, af[0], af[1], af[2], af[3]); }
            }
            const float inv = 1.0f / (A0 + A1);
            const int l0 = shi(cnt, e0), l1 = shi(cnt, e1);
            cnt += (F.lane == e0 ? 1 : 0) + (F.lane == e1 ? 1 : 0);
            if (F.lane == r) { me0 = e0; me1 = e1; ml0 = l0; ml1 = l1; mw0 = A0 * inv; mw1 = A1 * inv; msc = rsc; }
        }
        if (F.lane < 16) wcnt[F.wave * 16 + F.lane] = cnt;
        __syncthreads();
        if (F.tid < 16) { int c8[8], tot = 0;
#pragma unroll
            for (int w = 0; w < 8; ++w) { c8[w] = wcnt[w * 16 + F.tid]; tot += c8[w]; }
            int base = (int)__hip_atomic_fetch_add((unsigned*)(F.ctl + CW_EXPCNT + (l * 16 + F.tid) * 64), (unsigned)tot, RLX_AGENT);
#pragma unroll
            for (int w = 0; w < 8; ++w) { wbase[w * 16 + F.tid] = base; base += c8[w]; } }
        __syncthreads();
        if (F.lane < 16) { const int row = rbase + F.lane, q0 = wbase[F.wave * 16 + me0] + ml0, q1 = wbase[F.wave * 16 + me1] + ml1;
            tok_e[row] = make_int2(me0, me1); tok_p[row] = make_int2(q0, q1);
            inv[(size_t)me0 * NTOK + q0] = row; inv[(size_t)me1 * NTOK + q1] = row; wtab[(size_t)me0 * NTOK + q0] = mw0; wtab[(size_t)me1 * NTOK + q1] = mw1;
            stab[(size_t)me0 * NTOK + q0] = msc; stab[(size_t)me1 * NTOK + q1] = msc; }
        __syncthreads();
    }
}
__device__ __forceinline__ void moe_combine_phase(const Frame& F, KArgs ap, int l) {
    const int nl = l + 1; const bool has_nl = nl < NLAYER;
    f32x4 nmul[4], nadd[4];
    if (has_nl) { const float* g = gin(ap, I_N1G) + (size_t)nl * DM; const float* sh = (const float*)(F.ws + WS_MOD) + ((size_t)nl * NB + 0) * 6 * DM; const float* sc = sh + DM;
#pragma unroll
        for (int j = 0; j < 4; ++j) { const int c = 4 * F.lane + 256 * j; nmul[j] = *(const f32x4*)(g + c) * (*(const f32x4*)(sc + c) + 1.0f); nadd[j] = *(const f32x4*)(sh + c); } }
    unsigned char* xn0 = F.ws + WS_SLOTS + (size_t)S_XN * SLOT; float* xs0 = (float*)(F.ws + WS_XS);
    moe_table(F, l);
    const LAS int* tcum = (const LAS int*)(F.lds + LDSCTL_OFF);
    const int2* tok_e = (const int2*)(F.ws + WS_TOKE); const int2* tok_p = (const int2*)(F.ws + WS_TOKP);
    const bf16* y = (const bf16*)(F.ws + MOE_AG); const float* mod = (const float*)(F.ws + WS_MOD); bf16* xb = (bf16*)(F.ws + WS_XB);
    const int gw = F.vcu * NWAVES + F.wave, NGW = F.G * NWAVES;
    constexpr int TQ = 4;
    for (int t0 = gw; t0 < NTOK; t0 += TQ * NGW) {
        f32x4 xv[TQ][4]; v2u xw[TQ][4], u0[TQ][4], u1[TQ][4];
#pragma unroll
        for (int q = 0; q < TQ; ++q) { const int t = (t0 + q * NGW < NTOK) ? t0 + q * NGW : t0; const int2 e = tok_e[t], p = tok_p[t];
            const int s0 = tcum[e.x] * 256 + p.x, s1 = tcum[e.y] * 256 + p.y;
            const v2u* xr = (const v2u*)(xb + (size_t)t * DM) + F.lane;
            const v2u* y0 = (const v2u*)(y + (size_t)s0 * DM) + F.lane; const v2u* y1 = (const v2u*)(y + (size_t)s1 * DM) + F.lane;
#pragma unroll
            for (int j = 0; j < 4; ++j) { xw[q][j] = xr[64 * j]; u0[q][j] = y0[64 * j]; u1[q][j] = y1[64 * j]; } }
#pragma unroll
        for (int q = 0; q < TQ; ++q) { const int t = t0 + q * NGW; if (t < NTOK) {
            const float* g2 = mod + ((size_t)l * NB + t / SEQ) * 6 * DM + 5 * DM;
            f32x4* xo = (f32x4*)(gout(ap) + (size_t)t * DM) + F.lane; v2u* xr = (v2u*)(xb + (size_t)t * DM) + F.lane;
#pragma unroll
            for (int j = 0; j < 4; ++j) { const f32x4 gv = *(const f32x4*)(g2 + 4 * F.lane + 256 * j); xv[q][j] = (f32x4){bflo(xw[q][j].x), bfhi(xw[q][j].x), bflo(xw[q][j].y), bfhi(xw[q][j].y)};
                const f32x4 yy = (f32x4){bflo(u0[q][j].x) + bflo(u1[q][j].x), bfhi(u0[q][j].x) + bfhi(u1[q][j].x), bflo(u0[q][j].y) + bflo(u1[q][j].y), bfhi(u0[q][j].y) + bfhi(u1[q][j].y)};
                xv[q][j] = xv[q][j] + gv * yy; if (has_nl) xr[64 * j] = (v2u){pk2(xv[q][j].x, xv[q][j].y), pk2(xv[q][j].z, xv[q][j].w)}; else __builtin_nontemporal_store(xv[q][j], &xo[64 * j]); }
            if (has_nl && t < SEQ) { float s = 0.f;
#pragma unroll
                for (int j = 0; j < 4; ++j) s += (xv[q][j].x * xv[q][j].x + xv[q][j].y * xv[q][j].y) + (xv[q][j].z * xv[q][j].z + xv[q][j].w * xv[q][j].w);
                const float rs = 1.0f / sqrtf(wave_sum(s, F.lane) * (1.0f / DM) + EPSN);
                f32x4 yv[4];
#pragma unroll
                for (int j = 0; j < 4; ++j) yv[j] = xv[q][j] * rs * nmul[j] + nadd[j];
                quant_row_store(yv, F.lane, xn0 + (size_t)t * DM, xs0 + t); } } }
    }
}
__device__ __forceinline__ void attention_phase(const Frame& F, KArgs ap, int l, unsigned char* slots, char* shm) {
    const attn128::bf16* Q = (const attn128::bf16*)(slots + (size_t)S_Q * SLOT); const attn128::bf16* K = (const attn128::bf16*)(slots + (size_t)S_K * SLOT);
    const attn128::bf16* V = (const attn128::bf16*)(slots + (size_t)S_V * SLOT); attn128::bf16* O0 = (attn128::bf16*)(slots + (size_t)S_O0 * SLOT);
    const float lam_init = (l == 0) ? 0.2f : 0.35550907f;
    const float d1 = wave_sum(gin(ap, I_LQ1)[l * 64 + F.lane] * gin(ap, I_LK1)[l * 64 + F.lane], F.lane), d2 = wave_sum(gin(ap, I_LQ2)[l * 64 + F.lane] * gin(ap, I_LK2)[l * 64 + F.lane], F.lane);
    const float lam = __uint_as_float((unsigned)__builtin_amdgcn_readfirstlane((int)__float_as_uint(__expf(d1) - __expf(d2) + lam_init)));
    float* gsc = (float*)(F.ws + WS_GSC);
    if (F.tid < 128) gsc[F.tid] = gin(ap, I_SUBLN)[l * 128 + F.tid] * (1.0f - lam_init);
    VM_WAIT(); __syncthreads();
    if (F.wave >= 4) __builtin_amdgcn_s_setprio(1);
    for (int j = 0;; ++j) {
        const int p = (j >> 2) * F.G + F.vcu; if (p >= 256) break;
        const int h = p >> 5, s = p & 31, c = (j >> 1) & 1, qb = (j & 1) ? 63 - s : s, hq = 2 * h + c;
        int tid_u = F.tid; asm volatile("" : "+v"(tid_u)); __builtin_assume((unsigned)tid_u < 512u);
        if (c == 0) attn128::attn_unit128<8, 0>(qb, Q + hq * 64, K + hq * 64, V + h * 128, O0 + h * 128, shm, tid_u, lam, gsc);
        else        attn128::attn_unit128<8, 1>(qb, Q + hq * 64, K + hq * 64, V + h * 128, O0 + h * 128, shm, tid_u, lam, gsc);
    }
    __builtin_amdgcn_s_setprio(0);
}

#ifndef SCAN_LB
#define SCAN_LB 1
#endif
constexpr int PHA = SCAN_LB ? 4 : 5;
constexpr int PH_PER_BATCH = PHA + 3, PH_MOE = 4, PH_PER_LAYER = 2 * PH_PER_BATCH + PH_MOE, N_PHASES = 1 + NLAYER * PH_PER_LAYER;
#ifndef ONLY_KIND
#define ONLY_KIND -1
#endif
#define KON(kind) (ONLY_KIND < 0 || ONLY_KIND == (kind))
#ifdef REP_KIND
#define RLOOP(k) for (int rep_ = 0, repn_ = ((REP_KIND == (k)) ? REP_N : 1); rep_ < repn_; ++rep_)
#else
#define RLOOP(k)
#endif
__global__ void __launch_bounds__(NWAVES * 64, 2) mk_fwd(Args args_in_kernarg_segment) {
    extern __shared__ __attribute__((aligned(16))) unsigned char lds[];
    Frame F0;
    F0.lds = (LAS unsigned char*)lds; F0.ldsg = lds;
    F0.tid = threadIdx.x; F0.lane = F0.tid & 63; F0.wave = __builtin_amdgcn_readfirstlane(F0.tid >> 6);
    F0.G = gridDim.x; F0.bid = blockIdx.x; { const int bx = blockIdx.x; F0.vcu = (F0.G % 8 == 0) ? (bx % 8) * (F0.G / 8) + bx / 8 : bx; }
    int lo, hi;
    { KArgs A = kargs(); F0.ws = A->ws; lo = A->ph_lo; hi = A->ph_hi; }
    F0.ctl = (gu32*)(F0.ws + WS_CTL);
    volatile LAS unsigned* MISC = (volatile LAS unsigned*)(F0.lds + MISC_OFF);
    for (int u = F0.tid; u < (LDS_BYTES - LDSCTL_OFF) / 4; u += NWAVES * 64) ((LAS unsigned*)(F0.lds + LDSCTL_OFF))[u] = 0u;
    __syncthreads();
    XcdBarrier bar; bar.bar = (unsigned*)(F0.ctl + CW_BAR); bar.x = 0; bar.st = nullptr;
    if (hi - lo > 1) bar = xcd_barrier_post((unsigned*)(F0.ctl + CW_BAR), MISC + 8);
#define IN(k) (lo <= (k) && (k) < hi)
#define SEAM(k) do { if (IN(k) && IN((k) + 1)) { XcdBarrier bb_ = bar; bb_.bar = (unsigned*)(kargs()->ws + WS_CTL) + CW_BAR; asm volatile("" : "+s"(bb_.x)); xcd_barrier(bb_); } } while (0)
#define WL(l) (P.ws + WS_W + (size_t)(l) * W_LAYER)
#define MODB(l, b) ((const float*)(P.ws + WS_MOD) + ((size_t)(l) * NB + (b)) * 6 * DM)
#define SLOTS (P.ws + WS_SLOTS)
#define PFRAME() asm volatile("" : "+v"(F0.tid)); __builtin_assume((unsigned)F0.tid < 512u); asm volatile("" : "+s"(F0.G), "+s"(F0.vcu), "+s"(F0.bid)); Frame P = F0; P.ws = kargs()->ws; P.lane = P.tid & 63; P.wave = __builtin_amdgcn_readfirstlane(P.tid >> 6); P.ctl = (gu32*)(P.ws + WS_CTL)

    if (KON(0) && IN(0)) { PFRAME(); KArgs A = kargs(); ada_mod(P, A); fold_pool_weights(P, A); rope_tables(P); conv_mixer_weights(P, A); }
    SEAM(0);

    for (int l = 0; l < NLAYER; ++l) {
        for (int b = 0; b < NB; ++b) {
            const int p0 = 1 + l * PH_PER_LAYER + b * PH_PER_BATCH;
#define PFRAME_LB() PFRAME(); asm volatile("" : "+s"(l), "+s"(b))
            if (KON(1) && IN(p0 + 0) && l == 0 && b == 0) { PFRAME_LB(); KArgs A = kargs();
                norm_rows<false>(P, gin(A, I_X), gin(A, I_N1G), MODB(0, 0), MODB(0, 0) + DM, SLOTS + (size_t)S_XN * SLOT, (float*)(P.ws + WS_XS), SEQ);
                quant_pool_cols(P); }
            if (l == 0 && b == 0) SEAM(p0 + 0);
            if (KON(2) && IN(p0 + 1)) RLOOP(2) { PFRAME_LB(); KArgs A = kargs();
                SchedTiles S{(const char*)SLOTS + (size_t)S_XN * SLOT, (const char*)WL(l) + W_IN, (size_t)256 * DM, (size_t)256 * DM, 0, SEQ / 256, INW / 256, P.G, P.bid};
                EpiInProj E{SLOTS, gin(A, I_QNG) + l * 64, gin(A, I_KNG) + l * 64, (const float*)(P.ws + WS_COS), (const float*)(P.ws + WS_SIN), (const float*)(P.ws + WS_XS), (const float*)(WL(l) + W_SB)};
                pg8::gemm_phase<EpiInProj, SchedTiles>(P.lds + RING_OFF, P.tid, DM / 2, DM / 2, DM / 2, S, E);
            }
            SEAM(p0 + 1);
            if (KON(3) && IN(p0 + 2)) RLOOP(3) { PFRAME_LB(); KArgs A = kargs(); conv_pool_phase(P, A, l, SLOTS);
                if (b == 0) {
                    if (l == 0) norm_rows<false>(P, gin(A, I_X) + (size_t)SEQ * DM, gin(A, I_N1G), MODB(0, 1), MODB(0, 1) + DM, SLOTS + (size_t)S_XN * SLOT, (float*)(P.ws + WS_XS), SEQ);
                    else norm_rows<true>(P, (const bf16*)(P.ws + WS_XB) + (size_t)SEQ * DM, gin(A, I_N1G) + (size_t)l * DM, MODB(l, 1), MODB(l, 1) + DM, SLOTS + (size_t)S_XN * SLOT, (float*)(P.ws + WS_XS), SEQ); } }
            SEAM(p0 + 2);
            if (KON(4) && IN(p0 + 3)) RLOOP(4) { PFRAME_LB(); KArgs A = kargs();
                SchedTiles S{(const char*)SLOTS + (size_t)S_XC * SLOT, (const char*)WL(l) + W_LRU, (size_t)256 * DM * 2, (size_t)256 * 128 * 2, (size_t)128 * 2, SEQ / 256, 8, P.G, P.bid};
                EpiLruGates E{SLOTS, gin(A, I_LBA) + (size_t)l * DM, gin(A, I_LBX) + (size_t)l * DM, gin(A, I_LL) + (size_t)l * DM};
                int kk = 128; asm volatile("" : "+s"(kk));
                pg8::gemm_phase<EpiLruGates, SchedTiles>(P.lds + RING_OFF, P.tid, kk, DM, 128, S, E);
            }
            SEAM(p0 + 3);
#if SCAN_LB
            if (KON(6) && IN(p0 + 4)) { PFRAME_LB(); scan_lookback_phase(P, SLOTS, 2 * l + b); }
#else
            if (KON(5) && IN(p0 + 4)) RLOOP(5) { PFRAME_LB(); scan_phase<1>(P, SLOTS); }
            SEAM(p0 + 4);
            if (KON(6) && IN(p0 + 5)) RLOOP(6) { PFRAME_LB(); scan_phase<2>(P, SLOTS); }
#endif
            if (KON(7) && IN(p0 + PHA)) { PFRAME_LB(); KArgs A = kargs(); attention_phase(P, A, l, SLOTS, (char*)lds + RING_OFF); }
            SEAM(p0 + PHA);
            if (KON(9) && IN(p0 + PHA + 1)) RLOOP(9) { PFRAME_LB();
                SchedMerge S{SLOTS, (const char*)WL(l) + W_BR, P.G, P.bid}; EpiMerge E{SLOTS, (unsigned)P.bid * 131072u};
                pg8::gemm_phase<EpiMerge, SchedMerge>(P.lds + RING_OFF, P.tid, DM, DM, DM, S, E);
            }
            SEAM(p0 + PHA + 1);
            if (KON(10) && IN(p0 + PHA + 2)) { PFRAME_LB(); KArgs A = kargs(); const void* xsrc = (l == 0) ? (const void*)gin(A, I_X) : (const void*)(P.ws + WS_XB);
                SchedTiles S{(const char*)SLOTS + (size_t)S_MERGED * SLOT, (const char*)WL(l) + W_OUT, (size_t)256 * DM * 2, (size_t)256 * DM * 2, 0, SEQ / 256, DM / 256, P.G, P.bid};
                EpiOut E{xsrc, (bf16*)(P.ws + WS_XB), MODB(l, b) + 2 * DM, b * SEQ, l == 0};
                pg8::gemm_phase<EpiOut, SchedTiles>(P.lds + RING_OFF, P.tid, DM, DM, DM, S, E);
            }
            SEAM(p0 + PHA + 2);
        }
#define PFRAME_L() PFRAME(); asm volatile("" : "+s"(l))
        const int q0 = 1 + l * PH_PER_LAYER + 2 * PH_PER_BATCH;
        if (KON(11) && IN(q0 + 0)) {
#pragma nounroll
            for (int st_ = 0; st_ < 2; ++st_) { PFRAME_L(); KArgs A = kargs(); asm volatile("" : "+s"(st_)); if ((st_ ^ (P.vcu & 1)) == 0) conv_moe_weights(P, A, l); else router_phase(P, A, l); } }
        SEAM(q0 + 0);
        if (KON(13) && IN(q0 + 1)) RLOOP(13) { PFRAME_L();
            moe_table(P, l);
            SchedMoe<true> S{(const char*)P.ws + MOE_XN, (const char*)P.ws + MOE_WGU, 0, (size_t)1024 * DM, (size_t)256 * DM, (const LAS int*)(P.lds + LDSCTL_OFF), (const int*)(P.ws + WS_INV), P.G, P.bid, P.tid};
            EpiMoe1 E{(bf16*)(P.ws + MOE_ACT), (const float*)(P.ws + WS_WTAB), (const float*)(P.ws + WS_STAB), (const float*)(P.ws + MOE_SB)};
            pg8::gemm_phase<EpiMoe1, SchedMoe<true>>(P.lds + RING_OFF, P.tid, DM / 2, DM / 2, DM / 2, S, E);
        }
        SEAM(q0 + 1);
        if (KON(14) && IN(q0 + 2)) RLOOP(14) { PFRAME_L();
            moe_table(P, l);
            SchedMoe<false> S{(const char*)P.ws + MOE_ACT, (const char*)P.ws + MOE_WD, (size_t)256 * DEXP * 2, (size_t)1024 * DEXP * 2, (size_t)256 * DEXP * 2, (const LAS int*)(P.lds + LDSCTL_OFF), nullptr, P.G, P.bid, P.tid};
            EpiMoe2 E{(bf16*)(P.ws + MOE_AG)};
            pg8::gemm_phase<EpiMoe2, SchedMoe<false>>(P.lds + RING_OFF, P.tid, DEXP, DEXP, DEXP, S, E);
        }
        SEAM(q0 + 2);
        if (KON(15) && IN(q0 + 3)) { PFRAME_L(); KArgs A = kargs(); moe_combine_phase(P, A, l); }
        SEAM(q0 + 3);
    }
#undef IN
#undef SEAM
}

extern "C" void kernel_launch(void* const* d_in, const int* in_sizes, int n_in, void* d_out, int out_size, void* d_ws, size_t ws_size, hipStream_t stream) {
    static int grid = 0;
    if (grid == 0) {
        if (n_in != 30 || in_sizes[0] != NTOK * DM || out_size != NTOK * DM || ws_size < WS_END) {
            fprintf(stderr, "kernel_launch: unexpected problem: n_in %d in0 %d out %d ws %zu (need %zu)\n", n_in, n_in > 0 ? in_sizes[0] : -1, out_size, ws_size, (size_t)WS_END); grid = -1; return; }
        int dev = 0, cus = 0, per_cu = 0;
        if (hipGetDevice(&dev) != hipSuccess || hipDeviceGetAttribute(&cus, hipDeviceAttributeMultiprocessorCount, dev) != hipSuccess) { grid = -1; return; }
        if (hipFuncSetAttribute((const void*)mk_fwd, hipFuncAttributeMaxDynamicSharedMemorySize, LDS_BYTES) != hipSuccess) { fprintf(stderr, "kernel_launch: hipFuncSetAttribute failed\n"); grid = -1; return; }
        if (hipOccupancyMaxActiveBlocksPerMultiprocessor(&per_cu, (const void*)mk_fwd, NWAVES * 64, LDS_BYTES) != hipSuccess || per_cu < 1)
            fprintf(stderr, "kernel_launch: note: occupancy query reports %d workgroups per CU\n", per_cu);
        (void)hipGetLastError();
        grid = cus;
    }
    if (grid < 0) return;
    if (hipMemsetAsync((char*)d_ws + WS_CTL, 0, CTL_ZERO_BYTES, stream) != hipSuccess) return;
    Args a{};
    for (int i = 0; i < 30; ++i) a.in[i] = (const float*)d_in[i];
    a.out = (float*)d_out; a.ws = (unsigned char*)d_ws;
#if MK_ONE_LAUNCH
    a.ph_lo = 0; a.ph_hi = N_PHASES;
    hipLaunchKernelGGL(mk_fwd, dim3(grid), dim3(NWAVES * 64), LDS_BYTES, stream, a);
#else
#ifndef MK_LAST
#define MK_LAST N_PHASES
#endif
    for (int k = 0; k < MK_LAST; ++k) { a.ph_lo = k; a.ph_hi = k + 1; hipLaunchKernelGGL(mk_fwd, dim3(grid), dim3(NWAVES * 64), LDS_BYTES, stream, a); }
#endif
}
```

```cpp
#include <hip/hip_runtime.h>
#include <hip/hip_bf16.h>
#include <cstdio>
#include <cstdint>
#include <cmath>

namespace pg8 {
#define PG8_LAS __attribute__((address_space(3)))
typedef unsigned short bf16_t;
typedef short bf16x8 __attribute__((ext_vector_type(8)));
typedef float f32x4 __attribute__((ext_vector_type(4)));
typedef float f32x2 __attribute__((ext_vector_type(2)));
typedef unsigned u32x4 __attribute__((ext_vector_type(4)));
typedef int i32x4 __attribute__((ext_vector_type(4)));
constexpr int BM = 256, BK = 64, HALF = 128, HTB = HALF * BK * 2  , STAGE_BYTES = 8 * HTB, NXCD = 8, WGM = 8;

__host__ __device__ __forceinline__ int lds_byte(int r, int c) { const int st = (r >> 4) * 2 + (c >> 5), rr = r & 15, cc = c & 31, ob = rr * 64 + cc * 2; return st * 1024 + (ob ^ (((ob >> 9) & 1) << 5)); }
__host__ __device__ __forceinline__ void stage_rc(int b, int& R, int& C) { const int st = b / 1024, sb = b % 1024, swz = sb ^ (((sb >> 9) & 1) << 5); R = (st >> 1) * 16 + swz / 64; C = (st & 1) * 32 + (swz % 64) / 2; }
__host__ __device__ __forceinline__ int perm32(int rho) { const int n = rho >> 4, i = rho & 15; return 8 * (i >> 2) + 4 * n + (i & 3); }

struct GUnit { const char* A; const char* B; int pm, pn, aux, aux2; unsigned va0[2], va1[2]; };

__device__ __forceinline__ bool static_tile(int i, int G, int c, int nM, int nN, int& pm, int& pn) {
    const int nwg = nM * nN; const long L = (long)i * G + c; if (L >= nwg) return false;
    int wgid = (int)L; { const int q = nwg / NXCD, r = nwg % NXCD, xcd = wgid % NXCD, off = wgid / NXCD; wgid = (xcd < r ? xcd * (q + 1) : r * (q + 1) + (xcd - r) * q) + off; }
    const int nig = WGM * nN, gid = wgid / nig, fm = gid * WGM, gsz = (nM - fm) < WGM ? (nM - fm) : WGM;
    pm = fm + ((wgid % nig) % gsz); pn = (wgid % nig) / gsz; return true;
}

__device__ __forceinline__ unsigned cvt_pk_bf16(float lo, float hi) { unsigned r; asm volatile("v_cvt_pk_bf16_f32 %0, %1, %2" : "=v"(r) : "v"(lo), "v"(hi)); return r; }

template <class Epi, class Sched, bool ALIGN_EPI = true, bool SP2 = true>
__device__ __forceinline__ void gemm_phase(PG8_LAS unsigned char* lds, const int tid, const int K, const int lda, const int ldb, const Sched& S, const Epi& E) {
    const int wid = __builtin_amdgcn_readfirstlane(tid >> 6), lane = tid & 63, wr = wid >> 2, wc = wid & 3, fr_k = lane & 15, fq_k = lane >> 4;
    static_assert(SP2 && ALIGN_EPI, "this build keeps only the two-super-phase loop with aligned epilogues");
    const int nt = K / BK;
    constexpr bool PRE = SP2 && ALIGN_EPI && Epi::NSTORE > 0;
    unsigned voffA, voffB;
    { int R, C; stage_rc(tid * 16, R, C); const int Rb = Epi::PERM ? ((R & ~31) + perm32(R & 31)) : R; voffA = (unsigned)(R * lda + C) * 2u; voffB = (unsigned)(Rb * ldb + C) * 2u; }
    const size_t pstepA = (size_t)64 * lda * 2, pstepB = (size_t)64 * ldb * 2;
    const size_t kstep = (size_t)(BK * 2);
    const size_t hstepA = (size_t)HALF * lda * 2, hstepB = (size_t)HALF * ldb * 2;
    const unsigned ldsw = (unsigned)wid * 1024u;
    const int aoff = lds_byte(wr * 64 + fr_k, fq_k * 8), boff = lds_byte(wc * 32 + fr_k, fq_k * 8);
#define PG8_SA(b, h) (((b) * 2 + (h)) * HTB)
#define PG8_SB(b, h) ((4 + (b) * 2 + (h)) * HTB)
#define PG8_STAGE2(bufoff, gbase, voff) do { _Pragma("unroll") for (int _i = 0; _i < 2; ++_i) \
        __builtin_amdgcn_global_load_lds((const unsigned*)((const char*)(gbase) + (voff)[_i]), (PG8_LAS unsigned*)(lds + (bufoff) + ldsw + _i * 8192), 16, 0, 0); } while (0)
#define PG8_STAGE1(bufoff, gbase, voff, pstep) do { unsigned vo_ = (voff); asm volatile("" : "+v"(vo_));     \
        _Pragma("unroll") for (int _i = 0; _i < 2; ++_i) \
        __builtin_amdgcn_global_load_lds((const unsigned*)((const char*)(gbase) + _i * (pstep) + vo_), (PG8_LAS unsigned*)(lds + (bufoff) + ldsw + _i * 8192), 16, 0, 0); } while (0)
#define PG8_STAGE(bufoff, gbase, voffB_) PG8_STAGE1(bufoff, gbase, voffB, pstepB)
#define PG8_STGA(bufoff, gbase, h, v0, v1) do { if constexpr (Sched::GATHER) { if ((h) == 0) PG8_STAGE2(bufoff, gbase, v0); else PG8_STAGE2(bufoff, gbase, v1); } else { PG8_STAGE1(bufoff, (gbase) + (h) * hstepA, voffA, pstepA); } } while (0)
#define PG8_LDA(dst, b, h) do { _Pragma("unroll") for (int m = 0; m < 4; ++m) _Pragma("unroll") for (int k = 0; k < 2; ++k) dst[m][k] = *(const PG8_LAS bf16x8*)(lds + PG8_SA(b, h) + aoff + m * 2048 + k * 1024); } while (0)
#define PG8_LDB(dst, b, h) do { _Pragma("unroll") for (int n = 0; n < 2; ++n) _Pragma("unroll") for (int k = 0; k < 2; ++k) dst[n][k] = *(const PG8_LAS bf16x8*)(lds + PG8_SB(b, h) + boff + n * 2048 + k * 1024); } while (0)
#define PG8_MMA(ai, bj, At, Bt) do { __builtin_amdgcn_s_setprio(1); _Pragma("unroll") for (int m = 0; m < 4; ++m) _Pragma("unroll") for (int n = 0; n < 2; ++n) _Pragma("unroll") for (int k = 0; k < 2; ++k) { \
        if constexpr (Epi::I8) acc[ai][bj][m][n] = __builtin_bit_cast(f32x4, __builtin_amdgcn_mfma_i32_16x16x64_i8(__builtin_bit_cast(i32x4, Bt[n][k]), __builtin_bit_cast(i32x4, At[m][k]), __builtin_bit_cast(i32x4, acc[ai][bj][m][n]), 0, 0, 0)); \
        else acc[ai][bj][m][n] = __builtin_amdgcn_mfma_f32_16x16x32_bf16(Bt[n][k], At[m][k], acc[ai][bj][m][n], 0, 0, 0); } __builtin_amdgcn_s_setprio(0); } while (0)
#define PG8_WAIT_V(n) asm volatile("s_waitcnt vmcnt(" #n ")" ::: "memory")
#define PG8_WAIT_VR(FRESH) do { if constexpr ((FRESH) && Epi::NSTORE == 16) asm volatile("s_waitcnt vmcnt(24)" ::: "memory"); else if constexpr ((FRESH) && Epi::NSTORE == 8) asm volatile("s_waitcnt vmcnt(16)" ::: "memory"); else asm volatile("s_waitcnt vmcnt(8)" ::: "memory"); } while (0)
#define PG8_WAIT_L(n) asm volatile("s_waitcnt lgkmcnt(" #n ")" ::: "memory")
#define PG8_BAR __builtin_amdgcn_s_barrier()
#define PG8_SCHED __builtin_amdgcn_sched_barrier(0)
#define PG8_BODY(FRESH) do { \
            PG8_LDB(B0, 0, 0); PG8_LDB(B1, 0, 1); PG8_SCHED; PG8_LDA(At, 0, 0); if constexpr (!(FRESH)) PG8_STGA(PG8_SA(1, 1), a1, 1, cur.va0, cur.va1); \
            PG8_WAIT_VR(FRESH); PG8_WAIT_L(0); PG8_BAR; PG8_MMA(0, 0, At, B0); PG8_MMA(0, 1, At, B1); PG8_BAR; PG8_SCHED; \
            PG8_LDA(At, 0, 1); PG8_STAGE(PG8_SB(0, 0), b2, voffB); PG8_STAGE(PG8_SB(0, 1), b2 + hstepB, voffB); PG8_STGA(PG8_SA(0, 0), a2, 0, x0, x1); \
            PG8_WAIT_VR(FRESH); PG8_WAIT_L(0); PG8_BAR; PG8_MMA(1, 0, At, B0); PG8_MMA(1, 1, At, B1); PG8_BAR; PG8_SCHED; \
            PG8_LDB(B0, 1, 0); PG8_LDB(B1, 1, 1); PG8_SCHED; PG8_LDA(At, 1, 0); PG8_STGA(PG8_SA(0, 1), a2, 1, x0, x1); \
            PG8_WAIT_VR(FRESH); PG8_WAIT_L(0); PG8_BAR; PG8_MMA(0, 0, At, B0); PG8_MMA(0, 1, At, B1); PG8_BAR; PG8_SCHED; \
            PG8_LDA(At, 1, 1); PG8_STAGE(PG8_SB(1, 0), b3, voffB); PG8_STAGE(PG8_SB(1, 1), b3 + hstepB, voffB); PG8_STGA(PG8_SA(1, 0), a3, 0, x0, x1); \
            PG8_WAIT_V(8); PG8_WAIT_L(0); PG8_BAR; PG8_MMA(1, 0, At, B0); PG8_MMA(1, 1, At, B1); PG8_BAR; PG8_SCHED; } while (0)
    GUnit cur, nxt; int ui = 0;
    if (!S.next(0, cur)) return;
    f32x4 acc[2][2][4][2];
#pragma unroll
    for (int a = 0; a < 2; ++a)
#pragma unroll
        for (int b = 0; b < 2; ++b)
#pragma unroll
            for (int m = 0; m < 4; ++m)
#pragma unroll
                for (int n = 0; n < 2; ++n) acc[a][b][m][n] = (f32x4){0.f, 0.f, 0.f, 0.f};
    bf16x8 At[4][2], B0[2][2], B1[2][2];
    const char* cA = cur.A; const char* cB = cur.B;
    if constexpr (SP2) {
        PG8_STAGE(PG8_SB(0, 0), cB, voffB); PG8_STAGE(PG8_SB(0, 1), cB + hstepB, voffB); PG8_STGA(PG8_SA(0, 0), cA, 0, cur.va0, cur.va1); PG8_STGA(PG8_SA(0, 1), cA, 1, cur.va0, cur.va1);
        if (wr == 1) PG8_BAR;
        PG8_WAIT_V(2); PG8_BAR;
        PG8_STAGE(PG8_SB(1, 0), cB + kstep, voffB); PG8_STGA(PG8_SA(1, 0), cA + kstep, 0, cur.va0, cur.va1); PG8_STAGE(PG8_SB(1, 1), cB + hstepB + kstep, voffB);
        if constexpr (PRE) { PG8_STGA(PG8_SA(1, 1), cA + kstep, 1, cur.va0, cur.va1); PG8_WAIT_V(0); PG8_BAR; }
        else { PG8_WAIT_V(6); PG8_BAR; }
    }
    for (;;) {
        const bool has_next = S.next(ui + 1, nxt);
        const char* nA = has_next ? nxt.A : cA; const char* nB = has_next ? nxt.B : cB;
        if constexpr (Sched::GATHER) { if (!has_next) { nxt.va0[0] = cur.va0[0]; nxt.va0[1] = cur.va0[1]; nxt.va1[0] = cur.va1[0]; nxt.va1[1] = cur.va1[1]; } }
#define PG8_TRIP(FRESH) do { \
            const bool last = (t == nt - 2); \
            const char* a1 = cA + (size_t)(t + 1) * kstep; \
            const char* a2 = last ? nA : cA + (size_t)(t + 2) * kstep; const char* b2 = last ? nB : cB + (size_t)(t + 2) * kstep; \
            const char* a3 = a2 + kstep; const char* b3 = b2 + kstep; \
            unsigned x0[2], x1[2]; \
            if constexpr (Sched::GATHER) { x0[0] = last ? nxt.va0[0] : cur.va0[0]; x0[1] = last ? nxt.va0[1] : cur.va0[1]; x1[0] = last ? nxt.va1[0] : cur.va1[0]; x1[1] = last ? nxt.va1[1] : cur.va1[1]; } \
            PG8_BODY(FRESH); } while (0)
        if constexpr (SP2) {
            if constexpr (PRE) { { const int t = 0; PG8_TRIP(true); }
                for (int t = 2; t < nt; t += 2) PG8_TRIP(false); }
            else { for (int t = 0; t < nt; t += 2) PG8_TRIP(false); }
        }
        if constexpr (ALIGN_EPI) { if (wr == 0) PG8_BAR; }
        if constexpr (PRE) { if (has_next) PG8_STGA(PG8_SA(1, 1), nA + kstep, 1, nxt.va0, nxt.va1); }
        int tl_ = tid; asm volatile("" : "+v"(tl_)); const int fr = tl_ & 15, fq = (tl_ >> 4) & 3;
        if constexpr (Epi::I8) {
            const float* sap = E.sa_ptr(cur); const float* sbp = E.sb_ptr(cur);
            f32x4 sbv[2][2];
#pragma unroll
            for (int bj = 0; bj < 2; ++bj)
#pragma unroll
                for (int n = 0; n < 2; ++n) sbv[bj][n] = *(const f32x4*)((const char*)sbp + (unsigned)(bj * HALF + wc * 32 + 8 * fq + 4 * n) * 4u);
#pragma unroll
            for (int ai = 0; ai < 2; ++ai) {
                float sav[4];
#pragma unroll
                for (int m = 0; m < 4; ++m) sav[m] = *(const float*)((const char*)sap + (unsigned)(ai * HALF + wr * 64 + m * 16 + fr) * 4u);
#pragma unroll
                for (int m = 0; m < 4; ++m) { const float s = sav[m];
#pragma unroll
                    for (int bj = 0; bj < 2; ++bj)
#pragma unroll
                        for (int n = 0; n < 2; ++n) { const i32x4 iv = __builtin_bit_cast(i32x4, acc[ai][bj][m][n]);
                            acc[ai][bj][m][n] = (f32x4){(float)iv.x, (float)iv.y, (float)iv.z, (float)iv.w} * (sbv[bj][n] * s); } } }
        }
        E(acc, cur, wr, wc, fr, fq);
        if (!has_next) break;
#pragma unroll
        for (int a = 0; a < 2; ++a)
#pragma unroll
            for (int b = 0; b < 2; ++b)
#pragma unroll
                for (int m = 0; m < 4; ++m)
#pragma unroll
                    for (int n = 0; n < 2; ++n) acc[a][b][m][n] = (f32x4){0.f, 0.f, 0.f, 0.f};
        cur = nxt; cA = nA; cB = nB; ++ui;
        if constexpr (ALIGN_EPI) { if (wr == 1) PG8_BAR; }
    }
    PG8_WAIT_V(0);
    if constexpr (!ALIGN_EPI) { if (wr == 0) PG8_BAR; }
    PG8_BAR;
#undef PG8_SA
#undef PG8_SB
#undef PG8_STAGE
#undef PG8_STAGE1
#undef PG8_STAGE2
#undef PG8_STGA
#undef PG8_LDA
#undef PG8_LDB
#undef PG8_MMA
#undef PG8_WAIT_V
#undef PG8_WAIT_VR
#undef PG8_WAIT_L
#undef PG8_BAR
#undef PG8_SCHED
#undef PG8_BODY
#undef PG8_TRIP
}
}
#include <hip/hip_bf16.h>
#include <cmath>
namespace attn128 {
using bf16=__hip_bfloat16;
using bf16x8=__attribute__((ext_vector_type(8)))short;
using s16x4=__attribute__((ext_vector_type(4)))short;
using f32x16=__attribute__((ext_vector_type(16)))float;
using u32x4=__attribute__((ext_vector_type(4)))unsigned;
constexpr int NHEAD=16,SEQ=16384,D=64,DM=NHEAD*D;
constexpr int NW=8,QBLK=32,QB=QBLK*NW,KVBLK=64,NQB=SEQ/QB;
constexpr int ATTN_PITCH=DM, ATTN_UNIT_ROWS=QB;
__device__ __forceinline__ int crow(int r,int hi){return (r&3)+8*(r>>2)+4*hi;}
#define SBAR() __builtin_amdgcn_sched_barrier(0)
__device__ __forceinline__ void cmask(f32x16&p0,f32x16&p1,int jb,int qrel,int hi){
  const float NEG=-INFINITY; int kb=64*jb+4*hi;
  #pragma unroll
  for(int r=0;r<16;++r){int kv=kb+(r&3)+8*(r>>2); if(kv>qrel)p0[r]=NEG; if(kv+32>qrel)p1[r]=NEG;}
}

constexpr int NSLOT=3, SLOTB=8192;
constexpr int VSLOTB=2*SLOTB;
constexpr int LDS_K=0, LDS_V=NSLOT*SLOTB, LDS_WS=LDS_V+NSLOT*VSLOTB, LDS_OST=LDS_WS+NW*64*4, LDS_BYTES=LDS_OST+NW*4096;
constexpr float C2=0.125f*1.4426950408889634f;
__device__ __forceinline__ void glds16(const void*sbase,unsigned voff,unsigned lds_dst){unsigned keep;
  asm volatile("s_mov_b32 %0, m0\n\ts_mov_b32 m0, %3\n\ts_nop 0\n\tglobal_load_lds_dwordx4 %1, %2\n\ts_mov_b32 m0, %0":"=&s"(keep):"v"(voff),"s"(sbase),"s"(lds_dst):"memory");}
__device__ __forceinline__ float max3f(float a,float b,float c){float r;asm("v_max3_f32 %0, %1, %2, %3":"=v"(r):"v"(a),"v"(b),"v"(c));return r;}
__device__ __forceinline__ float max2f(float a,float b){float r;asm("v_max_f32_e32 %0, %1, %2":"=v"(r):"v"(a),"v"(b));return r;}
__device__ __forceinline__ float fadd_s(float a,float b){float r;asm("v_add_f32_e32 %0, %1, %2":"=v"(r):"v"(a),"v"(b));return r;}
__device__ __forceinline__ float fsub_s(float a,float b){float r;asm("v_sub_f32_e32 %0, %1, %2":"=v"(r):"v"(a),"v"(b));return r;}
typedef float f32x2_t __attribute__((ext_vector_type(2))); typedef float f32x4_t __attribute__((ext_vector_type(4))); typedef __bf16 bf16x2_t __attribute__((ext_vector_type(2)));
__device__ __forceinline__ unsigned cvtpk_s(float lo,float hi){f32x2_t v={lo,hi};bf16x2_t b=__builtin_convertvector(v,bf16x2_t);return __builtin_bit_cast(unsigned,b);}
#define WAIT_BAR(N) asm volatile("s_waitcnt vmcnt(" #N ") lgkmcnt(0)\n\ts_barrier":::"memory")

__device__ __forceinline__ void qkt(f32x16&p0,f32x16&p1,const char*Kslot,const bf16x8*qr,const f32x16&negm,int r32,int hi){
  const char*kb=Kslot+(r32>>4)*2048+hi*256+(r32&15)*16;
  #pragma unroll
  for(int d0=0;d0<4;++d0){
    const bf16x8 b0=*reinterpret_cast<const bf16x8*>(kb+d0*512);
    const bf16x8 b1=*reinterpret_cast<const bf16x8*>(kb+d0*512+4096);
    if(d0==0){p0=__builtin_amdgcn_mfma_f32_32x32x16_bf16(b0,qr[0],negm,0,0,0);p1=__builtin_amdgcn_mfma_f32_32x32x16_bf16(b1,qr[0],negm,0,0,0);}
    else{p0=__builtin_amdgcn_mfma_f32_32x32x16_bf16(b0,qr[d0],p0,0,0,0);p1=__builtin_amdgcn_mfma_f32_32x32x16_bf16(b1,qr[d0],p1,0,0,0);}}
}
typedef __attribute__((address_space(3))) const char* lds_cptr;
typedef short v4i16_t __attribute__((ext_vector_type(4)));
__device__ __forceinline__ void kload8(bf16x8*kf,lds_cptr kp){
  kf[0]=*(const __attribute__((address_space(3))) bf16x8*)(kp);      kf[1]=*(const __attribute__((address_space(3))) bf16x8*)(kp+4096);
  kf[2]=*(const __attribute__((address_space(3))) bf16x8*)(kp+512);  kf[3]=*(const __attribute__((address_space(3))) bf16x8*)(kp+4608);
  kf[4]=*(const __attribute__((address_space(3))) bf16x8*)(kp+1024); kf[5]=*(const __attribute__((address_space(3))) bf16x8*)(kp+5120);
  kf[6]=*(const __attribute__((address_space(3))) bf16x8*)(kp+1536); kf[7]=*(const __attribute__((address_space(3))) bf16x8*)(kp+5632);
}
__device__ __forceinline__ void kload2(bf16x8*kf,lds_cptr kp,int j){ kf[2*j]=*(const __attribute__((address_space(3))) bf16x8*)(kp+j*512); kf[2*j+1]=*(const __attribute__((address_space(3))) bf16x8*)(kp+j*512+4096); }
__device__ __forceinline__ s16x4 vtr(lds_cptr p){ return __builtin_bit_cast(s16x4,__builtin_amdgcn_ds_read_tr16_b64_v4i16((__attribute__((address_space(3))) v4i16_t*)p)); }
__device__ __forceinline__ float rowmax(const f32x16&p0,const f32x16&p1){
  float a=max3f(p0[0],p0[1],p1[0]),b=max3f(p0[2],p0[3],p1[1]);a=max3f(a,p1[2],p1[3]);
  #pragma unroll
  for(int r=4;r<16;r+=4){a=max3f(a,p0[r],p0[r+1]);b=max3f(b,p0[r+2],p0[r+3]);a=max3f(a,p1[r],p1[r+1]);b=max3f(b,p1[r+2],p1[r+3]);}
  const float m=max2f(a,b);
  auto rr=__builtin_amdgcn_permlane32_swap(__float_as_uint(m),__float_as_uint(m),false,false);
  return max2f(__uint_as_float(rr[0]),__uint_as_float(rr[1]));
}
__device__ __forceinline__ void pv(f32x16*o,int vb,bf16x8 pa0,bf16x8 pa1,bf16x8 pa2,bf16x8 pa3){
  #pragma unroll
  for(int d0=0;d0<4;++d0){s16x4 lo[4],hi[4];
    #pragma unroll
    for(int ks=0;ks<4;++ks){
      asm volatile("ds_read_b64_tr_b16 %0,%1 offset:%c2":"=&v"(lo[ks]):"v"(vb),"i"(d0*4096+ks*1024):"memory");
      asm volatile("ds_read_b64_tr_b16 %0,%1 offset:%c2":"=&v"(hi[ks]):"v"(vb),"i"(d0*4096+ks*1024+512):"memory");}
    asm volatile("s_waitcnt lgkmcnt(0)":::"memory");SBAR();
    #define PK(k) (bf16x8){lo[k][0],lo[k][1],lo[k][2],lo[k][3],hi[k][0],hi[k][1],hi[k][2],hi[k][3]}
    o[d0]=__builtin_amdgcn_mfma_f32_32x32x16_bf16(pa0,PK(0),o[d0],0,0,0);
    o[d0]=__builtin_amdgcn_mfma_f32_32x32x16_bf16(pa1,PK(1),o[d0],0,0,0);
    o[d0]=__builtin_amdgcn_mfma_f32_32x32x16_bf16(pa2,PK(2),o[d0],0,0,0);
    o[d0]=__builtin_amdgcn_mfma_f32_32x32x16_bf16(pa3,PK(3),o[d0],0,0,0);
    #undef PK
  }
}

#ifndef ATTN_STORE16
#define ATTN_STORE16(p,v) (*(u32x4*)(p)=(v))
#endif
template<int THRL,int MODE> __device__ __forceinline__ void attn_unit128(int qb,const bf16*Qh,const bf16*__restrict__ Kh,const bf16*__restrict__ Vh,bf16*Oh,char*shm,const int tid,const float lam,const float*gsc){
  const int lane=tid&63,r32=lane&31,hi=lane>>5; const int wid=__builtin_amdgcn_readfirstlane(tid>>6);
  const int q0=qb*QB;
  const bf16*Qw=Qh+(long)(q0+wid*QBLK)*DM;
  const unsigned lds0=(unsigned)(uintptr_t)shm;
  float*wsf=(float*)(shm+LDS_WS)+wid*64;
  const unsigned koff=(unsigned)((16*(wid>>1)+(lane&15))*DM+(4*(wid&1)+(lane>>4))*8)*2u, voff=(unsigned)((16*(wid&3)+(lane>>2))*DM+(wid>>2)*32+(lane&3)*8)*2u;
  const unsigned kdst=lds0+LDS_K+wid*1024, vdst=lds0+LDS_V+wid*1024;
  #define DMA_K(t,slot) glds16((const char*)Kh+(size_t)(t)*(KVBLK*DM*2),koff,(unsigned)__builtin_amdgcn_readfirstlane(kdst+(slot)))
  #define DMA_V(t,slot) do{ glds16((const char*)Vh+(size_t)(t)*(KVBLK*DM*2),voff,(unsigned)__builtin_amdgcn_readfirstlane(vdst+2*(slot))); glds16((const char*)Vh+128+(size_t)(t)*(KVBLK*DM*2),voff,(unsigned)__builtin_amdgcn_readfirstlane(vdst+2*(slot)+8192)); }while(0)
  const char*Kbase=shm+LDS_K; bf16x8 kf[8];
  const lds_cptr shm3=(lds_cptr)shm; const lds_cptr kp0=shm3+LDS_K+(r32>>4)*2048+hi*256+(r32&15)*16; const lds_cptr vp0=shm3+LDS_V+((lane>>4)&1)*32+(lane&3)*8+(4*hi+((lane&15)>>2))*64;
  const int NT=(q0+QB)/KVBLK;
  DMA_K(0,0);DMA_V(0,0);DMA_K(1,SLOTB);
  bf16x8 qr[4];
  #pragma unroll
  for(int d0=0;d0<4;++d0)qr[d0]=*reinterpret_cast<const bf16x8*>(&Qw[(long)r32*DM+d0*16+hi*8]);
  float mhat=0.f,l_reg=0.f;f32x16 o[4];o[0]=f32x16{};o[1]=f32x16{};o[2]=f32x16{};o[3]=f32x16{};f32x16 negm=f32x16{};asm volatile("":"+v"(negm));
  const int qrel=wid*QBLK+r32;
  #define CMASK(P0,P1,t) do{int jb_=(t)-(NT-4); if(jb_>=0)cmask(P0,P1,jb_,qrel,hi);}while(0)
  bool resc=false;
  #define START(P0,P1) do{ const float rm=rowmax(P0,P1); resc=false; \
    { const float dl=rm; mhat=fadd_s(mhat,dl); \
      _Pragma("unroll") for(int r=0;r<16;++r){P0[r]=fsub_s(P0[r],dl);P1[r]=fsub_s(P1[r],dl);} \
      _Pragma("unroll") for(int r=0;r<16;++r)negm[r]=-mhat; asm volatile("":"+v"(negm)); } \
    _Pragma("unroll") for(int r=0;r<16;++r)P0[r]=__builtin_amdgcn_exp2f(P0[r]); }while(0)
  #define RESC() do{ if(resc){ asm volatile("s_waitcnt lgkmcnt(0)":::"memory"); \
      _Pragma("unroll") for(int d_=0;d_<4;++d_) _Pragma("unroll") for(int r=0;r<16;++r)o[d_][r]*=wsf[crow(r,hi)]; } }while(0)
  f32x16 pA0,pA1,pB0,pB1;
  int sl_prev=0,sl_cur=0,sl_next=SLOTB;
  #define ROT() do{sl_prev=sl_cur;sl_cur=sl_next;sl_next=(sl_next==(NSLOT-1)*SLOTB)?0:sl_next+SLOTB;}while(0)
  DMA_K(2,2*SLOTB);
  WAIT_BAR(3);
  qkt(pA0,pA1,Kbase,qr,negm,r32,hi);asm volatile("s_nop 15\n\ts_nop 7":"+v"(pA0),"+v"(pA1));CMASK(pA0,pA1,0);
  START(pA0,pA1);
  _Pragma("unroll") for(int r=0;r<16;++r)pA1[r]=__builtin_amdgcn_exp2f(pA1[r]);
  WAIT_BAR(0);
  DMA_K(3,0);DMA_V(1,SLOTB);
  ROT();
  kload8(kf,kp0+sl_cur);
  WAIT_BAR(3);
  s16x4 vlo[4],vhi[4]; u32x4 pw0,pw1,pw2,pw3;
  #define PKW(P,B) cvtpk_s(P[B],P[B+1])
  #define PAF(k) __builtin_bit_cast(bf16x8,pw##k)
  #define VFR(s) (bf16x8){vlo[s][0],vlo[s][1],vlo[s][2],vlo[s][3],vhi[s][0],vhi[s][1],vhi[s][2],vhi[s][3]}
  #define PIN(x) asm volatile("":"+v"(x))
  #define MX3(a,b,c) __builtin_fmaxf(__builtin_fmaxf((a),(b)),(c))
  #define GAPA(MF,A0,A1,A2,A3,W0,W1,PW) do{ MF; sacc+=A0; sacc+=A1; sacc+=A2; sacc+=A3; PIN(sacc); W0; W1; PIN(PW); SBAR(); }while(0)
  #define EX(v) __builtin_amdgcn_exp2f(v)
  #define GAPB(MF,X,B) do{ MF; X[B]=EX(X[B]); X[B+1]=EX(X[B+1]); PIN(X); SBAR(); }while(0)
  #define VRD(i,s) do{ vlo[s]=vtr(vp_+(((i)>>2)*4096+((i)&3)*1024)); vhi[s]=vtr(vp_+(((i)>>2)*4096+((i)&3)*1024+512)); SBAR(); }while(0)
  #define KRD(G,j) do{ if(G){ kload2(kf,kp0+sl_next,j); SBAR(); } }while(0)
  #define PVM(g,k,s) o[g]=MFMA_(PAF(k),VFR(s),o[g],0,0,0)
  #define MFMA_ __builtin_amdgcn_mfma_f32_32x32x16_bf16
  #define STEP(C0,C1,P0,P1,t,GK,GV,GL) do{ SBAR(); \
    const lds_cptr vp_=vp0+2*sl_prev; \
    float sacc=(P0[0]+P0[1]); \
    GAPA(C0=MFMA_(kf[0],qr[0],negm,0,0,0), P0[2],P0[3],P0[4],P0[5],     pw0[0]=PKW(P0,0), pw0[1]=PKW(P0,2), pw0); \
    GAPA(C1=MFMA_(kf[1],qr[0],negm,0,0,0), P0[6],P0[7],P0[8],P0[9],     pw0[2]=PKW(P0,4), pw0[3]=PKW(P0,6), pw0); \
    GAPA(C0=MFMA_(kf[2],qr[1],C0,0,0,0),   P0[10],P0[11],P0[12],P0[13], pw1[0]=PKW(P0,8), pw1[1]=PKW(P0,10), pw1); \
    GAPA(C1=MFMA_(kf[3],qr[1],C1,0,0,0),   P0[14],P0[15],P1[0],P1[1],   pw1[2]=PKW(P0,12),pw1[3]=PKW(P0,14), pw1); \
    GAPA(C0=MFMA_(kf[4],qr[2],C0,0,0,0),   P1[2],P1[3],P1[4],P1[5],     pw2[0]=PKW(P1,0), pw2[1]=PKW(P1,2), pw2); \
    VRD(0,0); GAPA(C1=MFMA_(kf[5],qr[2],C1,0,0,0),   P1[6],P1[7],P1[8],P1[9],     pw2[2]=PKW(P1,4), pw2[3]=PKW(P1,6), pw2); \
    VRD(4,1); GAPA(C0=MFMA_(kf[6],qr[3],C0,0,0,0),   P1[10],P1[11],P1[12],P1[13], pw3[0]=PKW(P1,8), pw3[1]=PKW(P1,10), pw3); \
    VRD(8,2); GAPA(C1=MFMA_(kf[7],qr[3],C1,0,0,0),   P1[14],P1[15],0.f,0.f,       pw3[2]=PKW(P1,12),pw3[3]=PKW(P1,14), pw3); \
    l_reg+=sacc; \
    if(GK){DMA_K((t)+3,sl_cur);} if(GV){DMA_V((t)+1,sl_next);} \
    CMASK(C0,C1,t); \
    { float a=MX3(C0[0],C0[1],C1[0]),b=MX3(C0[2],C0[3],C1[1]); a=MX3(a,C1[2],C1[3]); \
      _Pragma("unroll") for(int r=4;r<16;r+=4){a=MX3(a,C0[r],C0[r+1]);b=MX3(b,C0[r+2],C0[r+3]);a=MX3(a,C1[r],C1[r+1]);b=MX3(b,C1[r+2],C1[r+3]);} \
      float rm=__builtin_fmaxf(a,b); { auto rr=__builtin_amdgcn_permlane32_swap(__float_as_uint(rm),__float_as_uint(rm),false,false); rm=__builtin_fmaxf(__uint_as_float(rr[0]),__uint_as_float(rr[1])); } \
      resc=false; \
      if(__builtin_expect(__any(rm>(float)THRL),0)){ const float dl=__builtin_fmaxf(rm,0.f); mhat+=dl; \
        _Pragma("unroll") for(int r=0;r<16;++r){C0[r]-=dl;C1[r]-=dl;} \
        _Pragma("unroll") for(int r=0;r<16;++r)negm[r]=-mhat; asm volatile("":"+v"(negm)); \
        const float f=__builtin_amdgcn_exp2f(-dl); l_reg*=f; if(hi==0)wsf[r32]=f; resc=true; } } \
    SBAR(); \
    VRD(12,3);            GAPB(PVM(0,0,0), C0,0); \
    VRD(1,0);             GAPB(PVM(1,0,1), C0,2); \
    VRD(5,1);             GAPB(PVM(2,0,2), C0,4); \
    VRD(9,2);             GAPB(PVM(3,0,3), C0,6); \
    VRD(13,3); KRD(GL,0); GAPB(PVM(0,1,0), C0,8); \
    VRD(2,0);             GAPB(PVM(1,1,1), C0,10); \
    VRD(6,1);  KRD(GL,1); GAPB(PVM(2,1,2), C0,12); \
    VRD(10,2);            GAPB(PVM(3,1,3), C0,14); \
    VRD(14,3); KRD(GL,2); GAPB(PVM(0,2,0), C1,0); \
    VRD(3,0);             GAPB(PVM(1,2,1), C1,2); \
    VRD(7,1);  KRD(GL,3); GAPB(PVM(2,2,2), C1,4); \
    VRD(11,2);            GAPB(PVM(3,2,3), C1,6); \
    VRD(15,3);            GAPB(PVM(0,3,0), C1,8); \
                          GAPB(PVM(1,3,1), C1,10); \
                          GAPB(PVM(2,3,2), C1,12); \
                          GAPB(PVM(3,3,3), C1,14); \
    }while(0)
  int t=1;
  #undef CMASK
  #define CMASK(P0,P1,t) do{}while(0)
  for(;t+5<NT;t+=2){
    STEP(pB0,pB1,pA0,pA1,t,true,true,true);     WAIT_BAR(3); RESC(); ROT();
    STEP(pA0,pA1,pB0,pB1,t+1,true,true,true);   WAIT_BAR(3); RESC(); ROT();
  }
  #undef CMASK
  #define CMASK(P0,P1,t) do{int jb_=(t)-(NT-4); if(jb_>=0)cmask(P0,P1,jb_,qrel,hi);}while(0)
  #define ENDW(tt) do{ if((tt)+3<NT){WAIT_BAR(3);} else if((tt)+2<NT){WAIT_BAR(2);} else {WAIT_BAR(0);} }while(0)
  for(;t+1<NT;t+=2){
    STEP(pB0,pB1,pA0,pA1,t,(t+3<NT),(t+1<NT),(t+1<NT));       ENDW(t);   RESC(); ROT();
    STEP(pA0,pA1,pB0,pB1,t+1,(t+4<NT),(t+2<NT),(t+2<NT));     ENDW(t+1); RESC(); ROT();
  }
  STEP(pB0,pB1,pA0,pA1,NT-1,false,false,false); RESC();
  { float sacc=pB0[0]+pB0[1]; _Pragma("unroll") for(int r=2;r<16;++r)sacc+=pB0[r]; _Pragma("unroll") for(int r=0;r<16;++r)sacc+=pB1[r]; l_reg+=sacc;
    pw0=(u32x4){PKW(pB0,0),PKW(pB0,2),PKW(pB0,4),PKW(pB0,6)};pw1=(u32x4){PKW(pB0,8),PKW(pB0,10),PKW(pB0,12),PKW(pB0,14)};pw2=(u32x4){PKW(pB1,0),PKW(pB1,2),PKW(pB1,4),PKW(pB1,6)};pw3=(u32x4){PKW(pB1,8),PKW(pB1,10),PKW(pB1,12),PKW(pB1,14)};
    SBAR(); const int vb0=(int)(lds0+LDS_V)+((lane>>4)&1)*32+(lane&3)*8+(4*hi+((lane&15)>>2))*64; pv(o,vb0+2*sl_cur,PAF(0),PAF(1),PAF(2),PAF(3)); }
  #undef PKW
  #undef PAF
  #undef VFR
  #undef PIN
  #undef MX3
  #undef GAPA
  #undef GAPB
  #undef EX
  #undef VRD
  #undef KRD
  #undef STEP
  #undef PVM
  #undef MFMA_
  #undef ENDW
  {auto rr=__builtin_amdgcn_permlane32_swap(__float_as_uint(l_reg),__float_as_uint(l_reg),false,false);l_reg=__uint_as_float(rr[0])+__uint_as_float(rr[1]);}
  if(hi==0)wsf[32+r32]=l_reg;asm volatile("s_waitcnt lgkmcnt(0)":::"memory");
  float rli[16];
  #pragma unroll
  for(int r=0;r<16;++r)rli[r]=__builtin_amdgcn_rcpf(wsf[32+crow(r,hi)]);
  bf16*Ow=Oh+(long)(q0+wid*QBLK)*DM;
  if constexpr(MODE==0){ bf16*stg=(bf16*)(shm+LDS_OST)+wid*2048;
    #pragma unroll
    for(int hf=0;hf<2;++hf){
      #pragma unroll
      for(int r=0;r<16;++r){const int orow=crow(r,hi);
        #pragma unroll
        for(int d0=0;d0<2;++d0)stg[orow*64+d0*32+r32]=__float2bfloat16(o[2*hf+d0][r]*rli[r]);}
      asm volatile("s_waitcnt lgkmcnt(0)":::"memory");
      #pragma unroll
      for(int i=0;i<4;++i){const int row=i*8+(lane>>3),ch=lane&7; const u32x4 v=*(const u32x4*)(stg+row*64+ch*8); ATTN_STORE16(Ow+(long)row*DM+hf*64+ch*8,v);}
      asm volatile("s_waitcnt lgkmcnt(0)":::"memory");
    } }
  else {
    asm volatile("s_waitcnt lgkmcnt(0)\n\ts_barrier":::"memory");
    bf16*stg=(bf16*)(shm+LDS_K)+wid*4096;
    #pragma unroll
    for(int r=0;r<16;++r){const int orow=crow(r,hi);
      #pragma unroll
      for(int d0=0;d0<4;++d0)stg[orow*128+d0*32+r32]=__float2bfloat16(o[d0][r]*rli[r]);}
    asm volatile("s_waitcnt lgkmcnt(0)":::"memory");
    const int rq=lane>>4,ch=lane&15;
    u32x4 a[8],b[8];
    #pragma unroll
    for(int k=0;k<8;++k){const int row=4*k+rq; a[k]=*(const u32x4*)(Ow+(long)row*DM+ch*8); b[k]=*(const u32x4*)(stg+row*128+ch*8);}
    const f32x4_t g0=*(const f32x4_t*)(gsc+8*ch),g1=*(const f32x4_t*)(gsc+8*ch+4);
    #pragma unroll
    for(int k=0;k<8;++k){ float dd[8],ss=0.f;
      #pragma unroll
      for(int i=0;i<4;++i){const unsigned ua=a[k][i],ub=b[k][i];
        const float d0=__uint_as_float(ua<<16)-lam*__uint_as_float(ub<<16),d1=__uint_as_float(ua&0xffff0000u)-lam*__uint_as_float(ub&0xffff0000u);
        dd[2*i]=d0;dd[2*i+1]=d1;ss+=d0*d0+d1*d1;}
      ss+=__int_as_float(__builtin_amdgcn_update_dpp(0,__float_as_int(ss),0xB1,0xF,0xF,true));
      ss+=__int_as_float(__builtin_amdgcn_update_dpp(0,__float_as_int(ss),0x4E,0xF,0xF,true));
      ss+=__int_as_float(__builtin_amdgcn_update_dpp(0,__float_as_int(ss),0x141,0xF,0xF,true));
      ss+=__int_as_float(__builtin_amdgcn_update_dpp(0,__float_as_int(ss),0x140,0xF,0xF,true));
      const float rs=1.0f/sqrtf(ss*(1.0f/128.0f)+1e-6f);
      u32x4 w;w[0]=cvtpk_s(dd[0]*rs*g0[0],dd[1]*rs*g0[1]);w[1]=cvtpk_s(dd[2]*rs*g0[2],dd[3]*rs*g0[3]);w[2]=cvtpk_s(dd[4]*rs*g1[0],dd[5]*rs*g1[1]);w[3]=cvtpk_s(dd[6]*rs*g1[2],dd[7]*rs*g1[3]);
      __builtin_nontemporal_store(w,(u32x4*)(Ow+(long)(4*k+rq)*DM+ch*8));}
  }
  asm volatile("s_waitcnt lgkmcnt(0)\n\ts_barrier":::"memory");
  #undef DMA_K
  #undef DMA_V
  #undef CMASK
  #undef START
  #undef RESC
  #undef ROT
}
constexpr int ATTN_LDS_BYTES=LDS_BYTES;
#undef SBAR
#undef WAIT_BAR
}

constexpr int NWAVES = 8;
#ifndef MK_ONE_LAUNCH
#define MK_ONE_LAUNCH 1
#endif

constexpr int NB = 2, SEQ = 16384, DM = 1024, NTOK = NB * SEQ, NLAYER = 2, INW = 9216;
constexpr int NEXP = 16, DEXP = 512, MOE_ROWS = 2 * NTOK + NEXP * 256;
constexpr float EPSN = 1e-6f;
constexpr float LOG2E = 1.4426950408889634f;

constexpr size_t MiB = 1u << 20;
constexpr size_t WS_CTL = 0, CTL_ZERO_BYTES = 1 * MiB;
constexpr size_t WS_MOD = 1 * MiB;
constexpr size_t WS_COS = 2 * MiB, WS_SIN = 4 * MiB;
constexpr size_t WS_SCANA = 6 * MiB, WS_SCANH = 8 * MiB;
constexpr size_t WS_TOKE = 7 * MiB, WS_TOKP = 7 * MiB + 512 * 1024;
constexpr size_t WS_INV = 10 * MiB, WS_WTAB = 12 * MiB;
constexpr size_t WS_XS = 9 * MiB + 512 * 1024, WS_XSA = 9 * MiB + 768 * 1024;
constexpr size_t WS_STAB = 14 * MiB;
constexpr size_t WS_GSC = 9 * MiB;
constexpr size_t WS_W = 16 * MiB, W_LAYER = 18 * MiB;
constexpr size_t WS_SLOTS_ = 52 * MiB;
constexpr size_t W_IN = 0, W_BR = 9 * MiB, W_OUT = 15 * MiB, W_LRU = 17 * MiB, W_SB = 17 * MiB + 512 * 1024;
constexpr size_t WS_POOLTMP = WS_SLOTS_ + 2 * (32u << 20);
constexpr size_t WS_SLOTS = 52 * MiB, SLOT = 32 * MiB;
constexpr size_t WS_XB = WS_SLOTS + 12 * SLOT;
constexpr size_t WS_END = WS_XB + 64 * MiB;
enum { S_XN = 0, S_XLRU = 1, S_Y = 2, S_Z = 3, S_Q = 4, S_K = 5, S_V = 6, S_G0 = 7, S_XC = 10, S_BRPOOL = 11,
       S_LA = 1, S_V2 = 3, S_O0 = 10, S_MERGED = 4 };
constexpr size_t MOE_XN = WS_SLOTS, MOE_AG = WS_SLOTS + 2 * SLOT, MOE_ACT = WS_SLOTS + 7 * SLOT, MOE_WGU = WS_SLOTS + 10 * SLOT, MOE_WD = WS_SLOTS + 11 * SLOT;
constexpr size_t MOE_SB = MOE_WGU + 16 * MiB;
static_assert(WS_SLOTS == WS_SLOTS_, "slots base");
static_assert((size_t)MOE_ROWS * DM * 2 <= 5 * SLOT && (size_t)MOE_ROWS * DEXP * 2 <= 3 * SLOT, "MoE overlay");
constexpr int CW_TMO = 0, CW_CODE = 1, CW_BAR = 4096, CW_EXPCNT = 16384, CW_SCANF = 32768;

constexpr int RING_OFF = 0, RING_BYTES = 131072;
constexpr int LDSCTL_OFF = RING_BYTES, MISC_OFF = LDSCTL_OFF + 320;
constexpr int LDS_BYTES = 147456;

#define GAS __attribute__((address_space(1)))
#define LAS __attribute__((address_space(3)))
typedef unsigned short bf16;
typedef unsigned v4u __attribute__((ext_vector_type(4)));
typedef unsigned v2u __attribute__((ext_vector_type(2)));
typedef float f32x4 __attribute__((ext_vector_type(4)));
typedef float f32x2 __attribute__((ext_vector_type(2)));
typedef GAS unsigned gu32;
#define RLX_AGENT __ATOMIC_RELAXED, __HIP_MEMORY_SCOPE_AGENT
#define LDS_WAIT() asm volatile("s_waitcnt lgkmcnt(0)" ::: "memory")
#define VM_WAIT() asm volatile("s_waitcnt vmcnt(0)" ::: "memory")
__device__ __forceinline__ unsigned pk2(float lo, float hi) { return pg8::cvt_pk_bf16(lo, hi); }
__device__ __forceinline__ float bflo(unsigned w) { return __uint_as_float(w << 16); }
__device__ __forceinline__ float bfhi(unsigned w) { return __uint_as_float(w & 0xffff0000u); }
__device__ __forceinline__ float fexp2(float x) { return __builtin_amdgcn_exp2f(x); }
__device__ __forceinline__ float frcp(float x) { return __builtin_amdgcn_rcpf(x); }
__device__ __forceinline__ float sigmoidf_(float z) { return frcp(1.0f + fexp2(-z * LOG2E)); }
__device__ __forceinline__ float gelu_tanh(float x) { const float u = 0.7978845608028654f * (x + 0.044715f * x * x * x); return x * frcp(1.0f + fexp2(-2.0f * LOG2E * u)); }
__device__ __forceinline__ float shx(float v, int lane, int o) { return __int_as_float(__builtin_amdgcn_ds_bpermute((lane ^ o) << 2, __float_as_int(v))); }
__device__ __forceinline__ int shi(int v, int src) { return __builtin_amdgcn_ds_bpermute(src << 2, v); }
__device__ __forceinline__ float red16(float (&t)[16]) {
#pragma unroll
    for (int j = 0; j < 8; ++j) { const auto r = __builtin_amdgcn_permlane32_swap(__float_as_uint(t[j]), __float_as_uint(t[j + 8]), false, false); t[j] = __uint_as_float(r[0]) + __uint_as_float(r[1]); }
#pragma unroll
    for (int j = 0; j < 4; ++j) { const auto r = __builtin_amdgcn_permlane16_swap(__float_as_uint(t[j]), __float_as_uint(t[j + 4]), false, false); t[j] = __uint_as_float(r[0]) + __uint_as_float(r[1]); }
#pragma unroll
    for (int j = 0; j < 2; ++j) { const int a = __float_as_int(t[j]), b = __float_as_int(t[j + 2]);
        const int x = __builtin_amdgcn_update_dpp(b, a, 0x140, 0xF, 0x3, false), y = __builtin_amdgcn_update_dpp(a, b, 0x140, 0xF, 0xC, false); t[j] = __int_as_float(y) + __int_as_float(x); }
    { const int a = __float_as_int(t[0]), b = __float_as_int(t[1]);
        const int x = __builtin_amdgcn_update_dpp(b, a, 0x141, 0xF, 0x5, false), y = __builtin_amdgcn_update_dpp(a, b, 0x141, 0xF, 0xA, false); t[0] = __int_as_float(y) + __int_as_float(x); }
    float v = t[0];
    v += __int_as_float(__builtin_amdgcn_update_dpp(0, __float_as_int(v), 0x4E, 0xF, 0xF, true));
    v += __int_as_float(__builtin_amdgcn_update_dpp(0, __float_as_int(v), 0xB1, 0xF, 0xF, true));
    return v;
}
__device__ __forceinline__ float wave_sum(float v, int lane) {
#pragma unroll
    for (int o = 1; o < 64; o <<= 1) v += shx(v, lane, o);
    return v;
}

__device__ __forceinline__ float wave_max(float v, int lane) {
#pragma unroll
    for (int o = 1; o < 64; o <<= 1) v = fmaxf(v, shx(v, lane, o));
    return v;
}
__device__ __forceinline__ unsigned pack_i8x4(float a, float b, float c, float d) {
    const int q0 = (int)rintf(a), q1 = (int)rintf(b), q2 = (int)rintf(c), q3 = (int)rintf(d);
    return (unsigned)(q0 & 0xff) | ((unsigned)(q1 & 0xff) << 8) | ((unsigned)(q2 & 0xff) << 16) | ((unsigned)q3 << 24);
}
__device__ __forceinline__ float quant_row_store(const f32x4 (&y)[4], int lane, unsigned char* dst, float* scale_slot) {
    float am = 0.f;
#pragma unroll
    for (int j = 0; j < 4; ++j) am = fmaxf(fmaxf(am, fmaxf(fabsf(y[j].x), fabsf(y[j].y))), fmaxf(fabsf(y[j].z), fabsf(y[j].w)));
    am = wave_max(am, lane);
    const float inv = am > 0.f ? 127.0f / am : 0.f, sc = am * (1.0f / 127.0f);
#pragma unroll
    for (int j = 0; j < 4; ++j) *(unsigned*)(dst + 4 * lane + 256 * j) = pack_i8x4(y[j].x * inv, y[j].y * inv, y[j].z * inv, y[j].w * inv);
    if (lane == 0) *scale_slot = sc;
    return sc;
}

#define XB_TMO      128
#define XB_XCNT(j)  (256  + 64 * (j))
#define XB_XSUB(j)  (1280 + 64 * (j))
#define XB_XGEN(j)  (2304 + 64 * (j))
#define XB_TOP      3328
#define XB_TOPGEN   3392
#define XCD_BAR_WORDS 3456
#define XB_SPIN_CAP (1u << 18)

__device__ __forceinline__ unsigned xb_ld(unsigned* p)              { return __hip_atomic_load(p, __ATOMIC_RELAXED, __HIP_MEMORY_SCOPE_AGENT); }
__device__ __forceinline__ unsigned xb_add(unsigned* p, unsigned v) { return __hip_atomic_fetch_add(p, v, __ATOMIC_RELAXED, __HIP_MEMORY_SCOPE_AGENT); }
__device__ __forceinline__ unsigned xb_xcc_id() { return (unsigned)__builtin_amdgcn_s_getreg((3 << 11) | 20) & 0xFu; }
#define XB_SPIN(cond, bar) do { unsigned _sp = 0; while (cond) { __builtin_amdgcn_s_sleep(1); \
    if ((++_sp & 255u) == 0u) { if (xb_ld(&(bar)[XB_TMO])) break; if (_sp > XB_SPIN_CAP) { atomicAdd(&(bar)[XB_TMO], 1u); break; } } } } while (0)

struct XcdBarrier {
    unsigned* bar; unsigned x;
    volatile LAS unsigned* st;
};

__device__ __forceinline__ XcdBarrier xcd_barrier_post(unsigned* bar, volatile LAS unsigned* st) {
    XcdBarrier b; b.bar = bar; b.x = xb_xcc_id(); b.st = st;
    if (threadIdx.x == 0) (void)xb_add(&bar[XB_XCNT(b.x)], 1u);
    return b;
}
__device__ __forceinline__ void xcd_barrier_complete(unsigned* bar, unsigned x, unsigned& nloc, unsigned& nx) {
    const unsigned G = gridDim.x * gridDim.y * gridDim.z;
    unsigned sum, cnt, mine, sp = 0u;
    for (;;) {
        sum = 0u; cnt = 0u; mine = 0u;
#pragma unroll
        for (unsigned j = 0; j < 16; ++j) { const unsigned c = xb_ld(&bar[XB_XCNT(j)]); sum += c; cnt += (c > 0u) ? 1u : 0u; mine = (j == x) ? c : mine; }
        if (sum == G) break;
        __builtin_amdgcn_s_sleep(1);
        if ((++sp & 255u) == 0u) { if (xb_ld(&bar[XB_TMO])) break; if (sp > XB_SPIN_CAP) { atomicAdd(&bar[XB_TMO], 1u); break; } }
    }
    nloc = mine > 0u ? mine : 1u; nx = cnt > 0u ? cnt : 1u;
}

__device__ __forceinline__ void xcd_barrier(const XcdBarrier& b) {
    asm volatile("s_waitcnt vmcnt(0)" ::: "memory");
    __syncthreads();
    if (threadIdx.x == 0) {
        unsigned* bar = b.bar;
        __builtin_amdgcn_s_waitcnt(0);
        unsigned nloc = b.st[0], nx = b.st[1];
        if (nloc == 0u) { xcd_barrier_complete(bar, b.x, nloc, nx); b.st[0] = nloc; b.st[1] = nx; }
        const unsigned old = xb_add(&bar[XB_XSUB(b.x)], 1u);
        const unsigned gen = old / nloc;
        if (old + 1u == (gen + 1u) * nloc) {
            __builtin_amdgcn_fence(__ATOMIC_RELEASE, "agent");
            asm volatile("s_waitcnt vmcnt(0)" ::: "memory");
            const unsigned og = xb_add(&bar[XB_TOP], 1u);
            const unsigned tg = og / nx;
            if (og + 1u == (tg + 1u) * nx) xb_add(&bar[XB_TOPGEN], 1u);
            else XB_SPIN(xb_ld(&bar[XB_TOPGEN]) == tg, bar);
            __builtin_amdgcn_fence(__ATOMIC_ACQUIRE, "agent");
            xb_add(&bar[XB_XGEN(b.x)], 1u);
            asm volatile("s_waitcnt vmcnt(0)" ::: "memory");
        } else {
            XB_SPIN(xb_ld(&bar[XB_XGEN(b.x)]) == gen, bar);
            __builtin_amdgcn_fence(__ATOMIC_ACQUIRE, "agent");
            asm volatile("s_waitcnt vmcnt(0)" ::: "memory");
        }
    }
    __syncthreads();
}

struct Args { const float* in[30]; float* out; unsigned char* ws; int ph_lo, ph_hi; };
static_assert(sizeof(Args) == 32 * 8 + 8, "Args has no padding");
enum { I_X = 0, I_C, I_WADA, I_BADA, I_N1G, I_N2G, I_WIN, I_CONVW, I_CONVB, I_LWA, I_LBA, I_LWX, I_LBX, I_LL, I_POOLW, I_POOLS, I_QNG, I_KNG,
       I_LQ1, I_LK1, I_LQ2, I_LK2, I_SUBLN, I_WBR, I_WOUT, I_RW, I_RB, I_WG, I_WU, I_WD };

typedef const __attribute__((address_space(4))) Args* KArgs;
__device__ __forceinline__ KArgs kargs() { KArgs p = (KArgs)__builtin_amdgcn_kernarg_segment_ptr(); asm volatile("" : "+s"(p)); return p; }
__device__ __forceinline__ const float* gin(KArgs ap, int i) { return (const float*)(const GAS float*)ap->in[i]; }
__device__ __forceinline__ float* gout(KArgs ap) { return (float*)(GAS float*)ap->out; }
struct Frame {
    LAS unsigned char* lds;
    unsigned char* ldsg;
    gu32* ctl;
    unsigned char* ws;
    int tid, lane, wave, vcu, G, bid;
};

__device__ __forceinline__ void transpose_item(const float* W, int ldw, int k0, int n0, bf16* dst, int ldd, LAS float* scr, int lane) {
    float tv[32];
#pragma unroll
    for (int i = 0; i < 32; ++i) tv[i] = W[(size_t)(k0 + 2 * i + (lane >> 5)) * ldw + n0 + (lane & 31)];
#pragma unroll
    for (int i = 0; i < 32; ++i) scr[(2 * i + (lane >> 5)) * 33 + (lane & 31)] = tv[i];
    LDS_WAIT(); asm volatile("" ::: "memory");
    const int c = lane & 7;
#pragma unroll
    for (int j = 0; j < 4; ++j) { const int n = (lane >> 3) + 8 * j; const LAS float* s = scr + (8 * c) * 33 + n;
        v4u o; o.x = pk2(s[0 * 33], s[1 * 33]); o.y = pk2(s[2 * 33], s[3 * 33]); o.z = pk2(s[4 * 33], s[5 * 33]); o.w = pk2(s[6 * 33], s[7 * 33]);
        *(v4u*)(dst + (size_t)n * ldd + k0 + 8 * c) = o; }
    LDS_WAIT(); asm volatile("" ::: "memory");
}
__device__ __forceinline__ void quant_cols_i8(const Frame& F, const float* W, int ldw, int n0, int K, unsigned char* dst, int ldd, float* sb) {
    LAS float* scr = (LAS float*)(F.lds + RING_OFF + F.wave * 16384); LAS float* red = (LAS float*)(F.lds + RING_OFF + 8 * 16384 - 1024);
    const int lane = F.lane, kw = K / 8, k0 = F.wave * kw;
    const unsigned rstep = (unsigned)ldw * 8u;
    const unsigned off0 = ((unsigned)(k0 + (lane >> 5)) * (unsigned)ldw + (unsigned)(n0 + (lane & 31))) * 4u;
    float am = 0.f, a[64];
#pragma unroll
    for (int u = 0; u < 64; ++u) a[u] = *(const float*)((const char*)W + off0 + (unsigned)u * rstep);
#pragma unroll
    for (int u = 0; u < 64; ++u) am = fmaxf(am, fabsf(a[u]));
    am = fmaxf(am, shx(am, lane, 32));
    __syncthreads();
    if (lane < 32) red[F.wave * 32 + lane] = am;
    __syncthreads();
#pragma unroll
    for (int w = 0; w < 8; ++w) am = fmaxf(am, red[w * 32 + (lane & 31)]);
    const float inv = am > 0.f ? 127.0f / am : 0.f;
    if (F.wave == 0 && lane < 32) sb[lane] = am * (1.0f / 127.0f);
#pragma unroll
    for (int jb = 0; jb < 2; ++jb) { const int kb = k0 + 64 * jb;
#pragma unroll
        for (int i = 0; i < 32; i += 8) {
            LAS float* sp = scr + (2 * i + (lane >> 5)) * 33 + (lane & 31);
#pragma unroll
            for (int u = 0; u < 8; ++u) sp[2 * u * 33] = a[32 * jb + i + u] * inv; }
        LDS_WAIT(); asm volatile("" ::: "memory");
        const int n = lane >> 1, hf = lane & 1; const LAS float* s = scr + (32 * hf) * 33 + n;
        v4u* o = (v4u*)(dst + (size_t)n * ldd + kb + 32 * hf);
#pragma unroll
        for (int h = 0; h < 2; ++h) { v4u w;
            w.x = pack_i8x4(s[(16 * h + 0) * 33], s[(16 * h + 1) * 33], s[(16 * h + 2) * 33], s[(16 * h + 3) * 33]);
            w.y = pack_i8x4(s[(16 * h + 4) * 33], s[(16 * h + 5) * 33], s[(16 * h + 6) * 33], s[(16 * h + 7) * 33]);
            w.z = pack_i8x4(s[(16 * h + 8) * 33], s[(16 * h + 9) * 33], s[(16 * h + 10) * 33], s[(16 * h + 11) * 33]);
            w.w = pack_i8x4(s[(16 * h + 12) * 33], s[(16 * h + 13) * 33], s[(16 * h + 14) * 33], s[(16 * h + 15) * 33]);
            o[h] = w; asm volatile("" ::: "memory"); }
        LDS_WAIT(); asm volatile("" ::: "memory");
    }
}
__device__ __forceinline__ int inproj_dst_row(int n0) {
    if (n0 >= 3072 && n0 < 5120) { const int tb = n0 & ~255, lc = (n0 >> 5) & 7; return tb + ((lc & 1) * 4 + (lc >> 1)) * 32; }
    return n0;
}
constexpr int MIXW_ITEMS = 1536 + 512 + 128;
__device__ __forceinline__ void conv_mixer_weights(const Frame& F, KArgs ap) {
    LAS float* scr = (LAS float*)(F.lds + RING_OFF + F.wave * 16384);
    const int gw = F.vcu * NWAVES + F.wave, NGW = F.G * NWAVES;
    for (int k = 0;; ++k) { int it;
        if (F.G == 256) { if (k >= (F.bid < 128 ? 1 : 3)) break; it = (k == 0) ? F.bid : 256 + 2 * (F.bid - 128) + (k - 1); }
        else { it = F.bid + k * F.G; if (it >= NLAYER * 256) break; }
        const int l = it >> 8, q = it & 255, n0 = (q < 64 ? q : q + 32) * 32, dr = inproj_dst_row(n0);
        unsigned char* wl = F.ws + WS_W + (size_t)l * W_LAYER;
        quant_cols_i8(F, gin(ap, I_WIN) + (size_t)l * DM * INW, INW, n0, DM, wl + W_IN + (size_t)dr * DM, DM, (float*)(wl + W_SB) + dr); }
    __syncthreads();
    for (int it = gw; it < NLAYER * MIXW_ITEMS; it += NGW) {
        const int l = it / MIXW_ITEMS; int r = it % MIXW_ITEMS;
        unsigned char* wl = F.ws + WS_W + (size_t)l * W_LAYER;
        if (r < 1536) { const int i = r / 512, q = r % 512, kb = q / 32, ch = q % 32;
            transpose_item(gin(ap, I_WBR) + ((size_t)l * 3 + i) * DM * DM, DM, kb * 64, ch * 32, (bf16*)(wl + W_BR) + ((size_t)i * DM + ch * 32) * DM, DM, scr, F.lane); continue; }
        r -= 1536;
        if (r < 512) { const int kb = r / 32, ch = r % 32;
            transpose_item(gin(ap, I_WOUT) + (size_t)l * DM * DM, DM, kb * 64, ch * 32, (bf16*)(wl + W_OUT) + (size_t)(ch * 32) * DM, DM, scr, F.lane); continue; }
        r -= 512;
        { const int which = r / 64, q = r % 64, n = q / 8, kb = (q % 8) / 4, ch = q % 4;
            const float* src = (which ? gin(ap, I_LWX) : gin(ap, I_LWA)) + ((size_t)l * 8 + n) * 128 * 128;
            transpose_item(src, 128, kb * 64, ch * 32, (bf16*)(wl + W_LRU) + ((size_t)n * 256 + which * 128 + ch * 32) * 128, 128, scr, F.lane); }
    }
}
constexpr int MOEW_ITEMS = 4096;
__device__ __forceinline__ void conv_moe_weights(const Frame& F, KArgs ap, int l) {
    LAS float* scr = (LAS float*)(F.lds + RING_OFF + F.wave * 16384);
    const int gw = F.vcu * NWAVES + F.wave, NGW = F.G * NWAVES;
    for (int it = F.bid; it < 512; it += F.G) { const int which = it >> 8, e = (it >> 4) & 15, f0 = (it & 15) * 32;
        const float* src = (which ? gin(ap, I_WU) : gin(ap, I_WG)) + ((size_t)l * NEXP + e) * DM * DEXP;
        const int row = e * 1024 + (f0 >> 7) * 256 + which * 128 + (f0 & 127);
        quant_cols_i8(F, src, DEXP, f0, DM, F.ws + MOE_WGU + (size_t)row * DM, DM, (float*)(F.ws + MOE_SB) + row); }
    __syncthreads();
    for (int it = gw; it < MOEW_ITEMS; it += NGW) { const int e = it / 256, q = it % 256, kb = q / 32, ch = q % 32;
        transpose_item(gin(ap, I_WD) + ((size_t)l * NEXP + e) * DEXP * DM, DM, kb * 64, ch * 32, (bf16*)(F.ws + MOE_WD) + ((size_t)e * 1024 + ch * 32) * DEXP, DEXP, scr, F.lane); }
}
__device__ __forceinline__ void fold_pool_weights(const Frame& F, KArgs ap) {
    LAS float* Wt = (LAS float*)(F.lds + RING_OFF);
    for (int it = F.bid; it < NLAYER * 4 * 16; it += F.G) {
        const int l = it / 64, g = (it / 16) & 3, kb = it & 15;
        const float* win = gin(ap, I_WIN) + (size_t)l * DM * INW + (size_t)(kb * 64) * INW + 2048 + g * 256;
        __syncthreads();
        for (int i = F.tid; i < 64 * 256; i += NWAVES * 64) Wt[i] = win[(size_t)(i >> 8) * INW + (i & 255)];
        __syncthreads();
        const int d = F.tid & 255, kh = F.tid >> 8;
        const float* pw = gin(ap, I_POOLW) + ((size_t)l * 4 + g) * 256 * 256 + d;
        float acc[32];
#pragma unroll
        for (int kk = 0; kk < 32; ++kk) acc[kk] = 0.f;
        for (int c = 0; c < 256; ++c) { const float p = pw[(size_t)c * 256];
#pragma unroll
            for (int kk = 0; kk < 32; ++kk) acc[kk] += Wt[(kh * 32 + kk) * 256 + c] * p; }
        float* dst = (float*)(F.ws + WS_POOLTMP) + ((size_t)l * 1024 + g * 256 + d) * DM + kb * 64 + kh * 32;
#pragma unroll
        for (int q = 0; q < 8; ++q) *(f32x4*)(dst + 4 * q) = (f32x4){acc[4 * q], acc[4 * q + 1], acc[4 * q + 2], acc[4 * q + 3]};
    }
    __syncthreads();
}
__device__ __forceinline__ void quant_pool_cols(const Frame& F) {
    const int gw = F.vcu * NWAVES + F.wave, NGW = F.G * NWAVES;
    for (int it = gw; it < NLAYER * 1024; it += NGW) {
        const int l = it >> 10, n = it & 1023;
        const f32x4* src = (const f32x4*)((const float*)(F.ws + WS_POOLTMP) + (size_t)it * DM) + F.lane;
        f32x4 y[4];
#pragma unroll
        for (int j = 0; j < 4; ++j) y[j] = src[64 * j];
        unsigned char* wl = F.ws + WS_W + (size_t)l * W_LAYER;
        quant_row_store(y, F.lane, wl + W_IN + (size_t)(2048 + n) * DM, (float*)(wl + W_SB) + 2048 + n);
    }
}
__device__ __forceinline__ void ada_mod(const Frame& F, KArgs ap) {
    LAS float* cact = (LAS float*)(F.lds + RING_OFF);
    LAS float* red = cact + 2048;
    __syncthreads();
    for (int i = F.tid; i < NB * DM; i += NWAVES * 64) { const float c = gin(ap, I_C)[i]; cact[i] = c * sigmoidf_(c); }
    __syncthreads();
    for (int it = F.bid; it < NLAYER * 6 * DM / 48; it += F.G) {
        const int j0 = it * 48, l = j0 / (6 * DM), j = (j0 % (6 * DM)) + (F.lane < 48 ? F.lane : 0);
        const float* w = gin(ap, I_WADA) + (size_t)l * DM * 6 * DM + j;
        float s0 = 0.f, s1 = 0.f;
        for (int k = F.wave * 128; k < F.wave * 128 + 128; ++k) { const float wv = w[(size_t)k * 6 * DM]; s0 += cact[k] * wv; s1 += cact[DM + k] * wv; }
        red[(F.wave * 2 + 0) * 64 + F.lane] = s0; red[(F.wave * 2 + 1) * 64 + F.lane] = s1;
        __syncthreads();
        if (F.tid < 96) { const int b = F.tid / 48, jj = F.tid % 48; float s = gin(ap, I_BADA)[(size_t)l * 6 * DM + (j0 % (6 * DM)) + jj];
#pragma unroll
            for (int w8 = 0; w8 < 8; ++w8) s += red[(w8 * 2 + b) * 64 + jj];
            ((float*)(F.ws + WS_MOD))[((size_t)l * NB + b) * 6 * DM + (j0 % (6 * DM)) + jj] = s; }
        __syncthreads();
    }
}
__device__ __forceinline__ void rope_tables(const Frame& F) {
    float* ct = (float*)(F.ws + WS_COS);
    for (int i = F.bid * (NWAVES * 64) + F.tid; i < SEQ * 32; i += F.G * NWAVES * 64) {
        const int pos = i >> 5, d = i & 31;
        const float inv = exp2f(-(float)(2 * d) * (1.0f / 64.0f) * 13.287712379549449f);
        const float ang = (float)pos * inv;
        const double rev = (double)ang * 0.15915494309189535; const float fr = (float)(rev - rint(rev));
        { const int fq = d >> 3, n = (d >> 2) & 1, e = d & 3; const size_t o = (size_t)pos * 64 + n * 16 + fq * 4 + e; ct[o] = __builtin_amdgcn_cosf(fr); ct[o + 32] = __builtin_amdgcn_sinf(fr); }
    }
}

template <bool SRCBF> __device__ __forceinline__ void norm_rows(const Frame& F, const void* src, const float* g, const float* sh, const float* sc, unsigned char* dst, float* xs, int nrows) {
    const int gw = F.vcu * NWAVES + F.wave, NGW = F.G * NWAVES;
    f32x4 mul[4], add[4];
#pragma unroll
    for (int j = 0; j < 4; ++j) { const int c = 4 * F.lane + 256 * j; const f32x4 gv = *(const f32x4*)(g + c), sv = *(const f32x4*)(sc + c); mul[j] = gv * (sv + 1.0f); add[j] = *(const f32x4*)(sh + c); }
    for (int r0 = gw; r0 < nrows; r0 += 4 * NGW) {
        f32x4 v[4][4];
#pragma unroll
        for (int q = 0; q < 4; ++q) { const int r = (r0 + q * NGW < nrows) ? r0 + q * NGW : r0;
            if constexpr (SRCBF) { const v2u* xr = (const v2u*)((const bf16*)src + (size_t)r * DM) + F.lane;
#pragma unroll
                for (int j = 0; j < 4; ++j) { const v2u w = xr[64 * j]; v[q][j] = (f32x4){bflo(w.x), bfhi(w.x), bflo(w.y), bfhi(w.y)}; } }
            else { const f32x4* xr = (const f32x4*)((const float*)src + (size_t)r * DM) + F.lane;
#pragma unroll
                for (int j = 0; j < 4; ++j) v[q][j] = xr[64 * j]; } }
#pragma unroll
        for (int q = 0; q < 4; ++q) { const int r = r0 + q * NGW; if (r < nrows) {
            float s = 0.f;
#pragma unroll
            for (int j = 0; j < 4; ++j) s += (v[q][j].x * v[q][j].x + v[q][j].y * v[q][j].y) + (v[q][j].z * v[q][j].z + v[q][j].w * v[q][j].w);
            const float rs = 1.0f / sqrtf(wave_sum(s, F.lane) * (1.0f / DM) + EPSN);
            f32x4 y[4];
#pragma unroll
            for (int j = 0; j < 4; ++j) y[j] = v[q][j] * rs * mul[j] + add[j];
            quant_row_store(y, F.lane, dst + (size_t)r * DM, xs + r); } }
    }
}
__device__ __forceinline__ void unpack8(const v4u w, float (&x)[8]) { x[0] = bflo(w.x); x[1] = bfhi(w.x); x[2] = bflo(w.y); x[3] = bfhi(w.y); x[4] = bflo(w.z); x[5] = bfhi(w.z); x[6] = bflo(w.w); x[7] = bfhi(w.w); }
__device__ __forceinline__ v4u pack8(const float (&x)[8]) { v4u w; w.x = pk2(x[0], x[1]); w.y = pk2(x[2], x[3]); w.z = pk2(x[4], x[5]); w.w = pk2(x[6], x[7]); return w; }
__device__ __forceinline__ void ld8f(const float* p, float (&x)[8]) { const f32x4 lo = *(const f32x4*)p, hi = *(const f32x4*)(p + 4); x[0] = lo.x; x[1] = lo.y; x[2] = lo.z; x[3] = lo.w; x[4] = hi.x; x[5] = hi.y; x[6] = hi.z; x[7] = hi.w; }
__device__ __forceinline__ void conv_pool_phase(const Frame& F, KArgs ap, int l, unsigned char* slots) {
    const bf16* __restrict__ xl = (const bf16*)(slots + S_XLRU * SLOT); bf16* __restrict__ xc = (bf16*)(slots + S_XC * SLOT);
    const bf16* __restrict__ z = (const bf16*)(slots + S_Z * SLOT); bf16* __restrict__ bp = (bf16*)(slots + S_BRPOOL * SLOT);
    const int gt = F.vcu * (NWAVES * 64) + F.tid, NT = F.G * NWAVES * 64;
    const v4u zero = (v4u){0u, 0u, 0u, 0u};
    for (int it = gt; it < 2 * 65536; it += NT) {
        const int which = it >> 16, r = it & 65535, cg = r & 127, t0 = (r >> 7) * 32, c0 = cg * 8;
        if (which == 0) {
            float w0[8], w1[8], w2[8], w3[8], cb[8], xm3[8], xm2[8], xm1[8];
            ld8f(gin(ap, I_CONVW) + ((size_t)l * 4 + 0) * DM + c0, w0); ld8f(gin(ap, I_CONVW) + ((size_t)l * 4 + 1) * DM + c0, w1);
            ld8f(gin(ap, I_CONVW) + ((size_t)l * 4 + 2) * DM + c0, w2); ld8f(gin(ap, I_CONVW) + ((size_t)l * 4 + 3) * DM + c0, w3);
            ld8f(gin(ap, I_CONVB) + (size_t)l * DM + c0, cb);
            unpack8(t0 >= 3 ? *(const v4u*)(xl + (size_t)(t0 - 3) * DM + c0) : zero, xm3);
            unpack8(t0 >= 2 ? *(const v4u*)(xl + (size_t)(t0 - 2) * DM + c0) : zero, xm2);
            unpack8(t0 >= 1 ? *(const v4u*)(xl + (size_t)(t0 - 1) * DM + c0) : zero, xm1);
            for (int tb = t0; tb < t0 + 32; tb += 8) {
                v4u in[8], ov[8];
#pragma unroll
                for (int u = 0; u < 8; ++u) in[u] = *(const v4u*)(xl + (size_t)(tb + u) * DM + c0);
#pragma unroll
                for (int u = 0; u < 8; ++u) { float x0[8], o[8]; unpack8(in[u], x0);
#pragma unroll
                    for (int i = 0; i < 8; ++i) { o[i] = cb[i] + w0[i] * xm3[i] + w1[i] * xm2[i] + w2[i] * xm1[i] + w3[i] * x0[i]; xm3[i] = xm2[i]; xm2[i] = xm1[i]; xm1[i] = x0[i]; }
                    ov[u] = pack8(o); }
#pragma unroll
                for (int u = 0; u < 8; ++u) *(v4u*)(xc + (size_t)(tb + u) * DM + c0) = ov[u];
            }
        } else {
            const int win = 2 << (cg >> 5);
            float sc[8], sum[8];
            ld8f(gin(ap, I_POOLS) + (size_t)l * DM + c0, sc);
#pragma unroll
            for (int i = 0; i < 8; ++i) sum[i] = 0.f;
            for (int s = (t0 - win > 0 ? t0 - win : 0); s < t0; ++s) { float x[8]; unpack8(*(const v4u*)(z + (size_t)s * DM + c0), x);
#pragma unroll
                for (int i = 0; i < 8; ++i) sum[i] += x[i]; }
            for (int tb = t0; tb < t0 + 32; tb += 8) {
                v4u in[8], old[8], ov[8];
#pragma unroll
                for (int u = 0; u < 8; ++u) { in[u] = *(const v4u*)(z + (size_t)(tb + u) * DM + c0); const int tp = tb + u - win; old[u] = *(const v4u*)(z + (size_t)(tp >= 0 ? tp : 0) * DM + c0); }
#pragma unroll
                for (int u = 0; u < 8; ++u) { float x0[8], xo[8], o[8]; const int t = tb + u; unpack8(in[u], x0); unpack8(t - win >= 0 ? old[u] : zero, xo);
                    const float rc = 1.0f / (float)(t + 1 < win ? t + 1 : win);
#pragma unroll
                    for (int i = 0; i < 8; ++i) { sum[i] += x0[i] - xo[i]; o[i] = (sum[i] * rc - x0[i]) * sc[i]; }
                    ov[u] = pack8(o); }
#pragma unroll
                for (int u = 0; u < 8; ++u) __builtin_nontemporal_store(ov[u], (v4u*)(bp + (size_t)(tb + u) * DM + c0));
            }
        }
    }
}
__device__ __forceinline__ void lru_au(float la, float v, float& a, float& u) {
    a = fexp2(la * LOG2E);
    const float x = 2.0f * la;
    const float om = (x > -0.3f) ? -x * (1.0f + x * 0.5f * (1.0f + x * (1.0f / 3.0f) * (1.0f + x * 0.25f * (1.0f + x * 0.2f)))) : 1.0f - a * a;
    u = sqrtf(om) * v;
}
constexpr int SCH = 64, NCHK = SEQ / SCH;
template <int PASS> __device__ __forceinline__ void scan_phase(const Frame& F, unsigned char* slots) {
    const bf16* __restrict__ la = (const bf16*)(slots + S_LA * SLOT); const bf16* __restrict__ v2 = (const bf16*)(slots + S_V2 * SLOT); bf16* y = (bf16*)(slots + S_Y * SLOT);
    bf16* yo = y;
    float* SA = (float*)(F.ws + WS_SCANA); float* SH = (float*)(F.ws + WS_SCANH);
    if (PASS == 1) {
        const int gt = F.vcu * (NWAVES * 64) + F.tid, NT = F.G * NWAVES * 64;
        for (int it = gt; it < NCHK * 512; it += NT) {
            const int ck = it >> 9, c0 = (it & 511) * 2, t0 = ck * SCH;
            float h0 = 0.f, h1 = 0.f, p0 = 0.f, p1 = 0.f;
            for (int tb = t0; tb < t0 + SCH; tb += 16) {
                unsigned lw[16], vw[16];
#pragma unroll
                for (int u = 0; u < 16; ++u) { lw[u] = *(const unsigned*)(la + (size_t)(tb + u) * DM + c0); vw[u] = *(const unsigned*)(v2 + (size_t)(tb + u) * DM + c0); }
#pragma unroll
                for (int u = 0; u < 16; ++u) {
                    float a0, u0, a1, u1; lru_au(bflo(lw[u]), bflo(vw[u]), a0, u0); lru_au(bfhi(lw[u]), bfhi(vw[u]), a1, u1);
                    h0 = a0 * h0 + u0; h1 = a1 * h1 + u1; p0 += bflo(lw[u]); p1 += bfhi(lw[u]); }
            }
            *(f32x2*)(SA + (size_t)ck * DM + c0) = (f32x2){fexp2(p0 * LOG2E), fexp2(p1 * LOG2E)}; *(f32x2*)(SH + (size_t)ck * DM + c0) = (f32x2){h0, h1};
        }
    } else {
        LAS f32x4* pl = (LAS f32x4*)(F.lds + RING_OFF);
        for (int item = F.vcu; item < NCHK; item += F.G) {
            const int cg = item >> 3, pb = item & 7, c0 = 2 * (64 * pb + F.lane), ck = 8 * cg + F.wave, t0 = ck * SCH;
            float A0 = 1.f, A1 = 1.f, H0 = 0.f, H1 = 0.f; asm volatile("" : "+v"(A0), "+v"(A1));
            for (int j0 = F.wave * cg, je = j0 + cg; j0 < je; j0 += 8) {
                f32x2 A[8], H[8];
#pragma unroll
                for (int u = 0; u < 8; ++u) { const int j = (j0 + u < je) ? j0 + u : je - 1; A[u] = *(const f32x2*)(SA + (size_t)j * DM + c0); H[u] = *(const f32x2*)(SH + (size_t)j * DM + c0); }
#pragma unroll
                for (int u = 0; u < 8; ++u) if (j0 + u < je) { H0 = A[u].x * H0 + H[u].x; H1 = A[u].y * H1 + H[u].y; A0 *= A[u].x; A1 *= A[u].y; }
            }
            f32x2 Ag[7], Hg[7];
#pragma unroll
            for (int u = 0; u < 7; ++u) { Ag[u] = *(const f32x2*)(SA + (size_t)(8 * cg + u) * DM + c0); Hg[u] = *(const f32x2*)(SH + (size_t)(8 * cg + u) * DM + c0); }
            __syncthreads();
            pl[F.wave * 64 + F.lane] = (f32x4){A0, A1, H0, H1};
            __syncthreads();
            float h0 = 0.f, h1 = 0.f;
#pragma unroll
            for (int sg = 0; sg < 8; ++sg) { const f32x4 q = pl[sg * 64 + F.lane]; h0 = q.x * h0 + q.z; h1 = q.y * h1 + q.w; }
#pragma unroll
            for (int u = 0; u < 7; ++u) if (u < F.wave) { h0 = Ag[u].x * h0 + Hg[u].x; h1 = Ag[u].y * h1 + Hg[u].y; }
            for (int tb = t0; tb < t0 + SCH; tb += 16) {
                unsigned lw[16], vw[16], yw[16], ow[16];
#pragma unroll
                for (int u = 0; u < 16; ++u) { lw[u] = *(const unsigned*)(la + (size_t)(tb + u) * DM + c0); vw[u] = *(const unsigned*)(v2 + (size_t)(tb + u) * DM + c0); yw[u] = *(const unsigned*)(y + (size_t)(tb + u) * DM + c0); }
#pragma unroll
                for (int u = 0; u < 16; ++u) {
                    float a0, u0, a1, u1; lru_au(bflo(lw[u]), bflo(vw[u]), a0, u0); lru_au(bfhi(lw[u]), bfhi(vw[u]), a1, u1);
                    h0 = a0 * h0 + u0; h1 = a1 * h1 + u1; ow[u] = pk2(h0 * bflo(yw[u]), h1 * bfhi(yw[u])); }
#pragma unroll
                for (int u = 0; u < 16; ++u) *(unsigned*)(yo + (size_t)(tb + u) * DM + c0) = ow[u];
            }
        }
    }
}

__device__ __forceinline__ void scan_lookback_phase(const Frame& F, unsigned char* slots, const int inst) {
    const bf16* __restrict__ la = (const bf16*)(slots + S_LA * SLOT); const bf16* __restrict__ v2 = (const bf16*)(slots + S_V2 * SLOT); bf16* y = (bf16*)(slots + S_Y * SLOT);
    unsigned* GA = (unsigned*)(F.ws + WS_SCANA) + (size_t)inst * 32 * DM; unsigned* GH = (unsigned*)(F.ws + WS_SCANH) + (size_t)inst * 32 * DM;
    LAS f32x4* pl = (LAS f32x4*)(F.lds + RING_OFF);
    LAS f32x4* pl2 = pl + 512;
    for (int item = F.vcu; item < NCHK; item += F.G) {
        const int cg = item >> 3, pb = item & 7, c0 = 2 * (64 * pb + F.lane), t0 = (8 * cg + F.wave) * SCH;
        float h0 = 0.f, h1 = 0.f, p0 = 0.f, p1 = 0.f;
        for (int tb = t0; tb < t0 + SCH; tb += 16) {
            unsigned lw[16], vw[16];
#pragma unroll
            for (int u = 0; u < 16; ++u) { lw[u] = *(const unsigned*)(la + (size_t)(tb + u) * DM + c0); vw[u] = *(const unsigned*)(v2 + (size_t)(tb + u) * DM + c0); }
#pragma unroll
            for (int u = 0; u < 16; ++u) { float a0, u0, a1, u1; lru_au(bflo(lw[u]), bflo(vw[u]), a0, u0); lru_au(bfhi(lw[u]), bfhi(vw[u]), a1, u1);
                h0 = a0 * h0 + u0; h1 = a1 * h1 + u1; p0 += bflo(lw[u]); p1 += bfhi(lw[u]); }
        }
        __syncthreads();
        pl[F.wave * 64 + F.lane] = (f32x4){fexp2(p0 * LOG2E), fexp2(p1 * LOG2E), h0, h1};
        __syncthreads();
        if (F.wave == 0) { float A0 = 1.f, A1 = 1.f, H0 = 0.f, H1 = 0.f; asm volatile("" : "+v"(A0), "+v"(A1));
#pragma unroll
            for (int sg = 0; sg < 8; ++sg) { const f32x4 q = pl[sg * 64 + F.lane]; H0 = q.x * H0 + q.z; H1 = q.y * H1 + q.w; A0 *= q.x; A1 *= q.y; }
            __hip_atomic_store(GA + (size_t)cg * DM + c0, __float_as_uint(A0), __ATOMIC_RELAXED, __HIP_MEMORY_SCOPE_AGENT); __hip_atomic_store(GA + (size_t)cg * DM + c0 + 1, __float_as_uint(A1), __ATOMIC_RELAXED, __HIP_MEMORY_SCOPE_AGENT);
            __hip_atomic_store(GH + (size_t)cg * DM + c0, __float_as_uint(H0), __ATOMIC_RELAXED, __HIP_MEMORY_SCOPE_AGENT); __hip_atomic_store(GH + (size_t)cg * DM + c0 + 1, __float_as_uint(H1), __ATOMIC_RELAXED, __HIP_MEMORY_SCOPE_AGENT); }
        asm volatile("s_waitcnt vmcnt(0)" ::: "memory");
        __syncthreads();
        gu32* fl = F.ctl + CW_SCANF + (size_t)inst * 4096;
        if (F.wave == 0) {
            if (F.lane == 0) { __builtin_amdgcn_fence(__ATOMIC_RELEASE, "agent"); asm volatile("s_waitcnt vmcnt(0)" ::: "memory");
                (void)xb_add((unsigned*)(fl + item * 16), 1u); }
            unsigned sp = 0;
            for (;;) { const unsigned ok = (F.lane < cg) ? xb_ld((unsigned*)(fl + (F.lane * 8 + pb) * 16)) : 1u;
                if (__builtin_amdgcn_ballot_w64(ok == 0u) == 0ull) break;
                __builtin_amdgcn_s_sleep(1);
                if ((++sp & 255u) == 0u) { unsigned* bar = (unsigned*)(F.ctl + CW_BAR); if (xb_ld(&bar[XB_TMO])) break; if (sp > XB_SPIN_CAP) { if (F.lane == 0) atomicAdd(&bar[XB_TMO], 1u); break; } } }
            if (F.lane == 0) { __builtin_amdgcn_fence(__ATOMIC_ACQUIRE, "agent"); asm volatile("s_waitcnt vmcnt(0)" ::: "memory"); }
        }
        __syncthreads();
        { const int cgs = (cg + 7) >> 3, j0 = F.wave * cgs, j1 = (j0 + cgs < cg) ? j0 + cgs : cg;
          float A0 = 1.f, A1 = 1.f, H0 = 0.f, H1 = 0.f; asm volatile("" : "+v"(A0), "+v"(A1));
          unsigned ga[4][2], gh[4][2];
#pragma unroll
          for (int k = 0; k < 4; ++k) { const int j = (j0 + k < j1) ? j0 + k : (j1 > 0 ? j1 - 1 : 0);
              ga[k][0] = __hip_atomic_load(GA + (size_t)j * DM + c0, __ATOMIC_RELAXED, __HIP_MEMORY_SCOPE_AGENT); ga[k][1] = __hip_atomic_load(GA + (size_t)j * DM + c0 + 1, __ATOMIC_RELAXED, __HIP_MEMORY_SCOPE_AGENT);
              gh[k][0] = __hip_atomic_load(GH + (size_t)j * DM + c0, __ATOMIC_RELAXED, __HIP_MEMORY_SCOPE_AGENT); gh[k][1] = __hip_atomic_load(GH + (size_t)j * DM + c0 + 1, __ATOMIC_RELAXED, __HIP_MEMORY_SCOPE_AGENT); }
#pragma unroll
          for (int k = 0; k < 4; ++k) if (j0 + k < j1) { const float a0 = __uint_as_float(ga[k][0]), a1 = __uint_as_float(ga[k][1]);
              H0 = a0 * H0 + __uint_as_float(gh[k][0]); H1 = a1 * H1 + __uint_as_float(gh[k][1]); A0 *= a0; A1 *= a1; }
          pl2[F.wave * 64 + F.lane] = (f32x4){A0, A1, H0, H1}; }
        __syncthreads();
        h0 = 0.f; h1 = 0.f;
#pragma unroll
        for (int sg = 0; sg < 8; ++sg) { const f32x4 q = pl2[sg * 64 + F.lane]; h0 = q.x * h0 + q.z; h1 = q.y * h1 + q.w; }
#pragma unroll
        for (int sg = 0; sg < 7; ++sg) if (sg < F.wave) { const f32x4 q = pl[sg * 64 + F.lane]; h0 = q.x * h0 + q.z; h1 = q.y * h1 + q.w; }
        for (int tb = t0; tb < t0 + SCH; tb += 16) {
            unsigned lw[16], vw[16], yw[16], ow[16];
#pragma unroll
            for (int u = 0; u < 16; ++u) { lw[u] = *(const unsigned*)(la + (size_t)(tb + u) * DM + c0); vw[u] = *(const unsigned*)(v2 + (size_t)(tb + u) * DM + c0); yw[u] = *(const unsigned*)(y + (size_t)(tb + u) * DM + c0); }
#pragma unroll
            for (int u = 0; u < 16; ++u) { float a0, u0, a1, u1; lru_au(bflo(lw[u]), bflo(vw[u]), a0, u0); lru_au(bfhi(lw[u]), bfhi(vw[u]), a1, u1);
                h0 = a0 * h0 + u0; h1 = a1 * h1 + u1; ow[u] = pk2(h0 * bflo(yw[u]), h1 * bfhi(yw[u])); }
#pragma unroll
            for (int u = 0; u < 16; ++u) __builtin_nontemporal_store(ow[u], (unsigned*)(y + (size_t)(tb + u) * DM + c0));
        }
    }
}

using pg8::GUnit;
typedef const pg8::f32x4 (&AccRef)[2][2][4][2];
__device__ __forceinline__ v4u pack_f4(const f32x4 a, const f32x4 b) { v4u w; w.x = pk2(a.x, a.y); w.y = pk2(a.z, a.w); w.z = pk2(b.x, b.y); w.w = pk2(b.z, b.w); return w; }
template <int ACT> __device__ __forceinline__ float actf(float v) { return ACT == 1 ? gelu_tanh(v) : (ACT == 2 ? sigmoidf_(v) : v); }
template <int ACT> __device__ __forceinline__ f32x4 act4(const f32x4 v) { f32x4 r = (f32x4){actf<ACT>(v.x), actf<ACT>(v.y), actf<ACT>(v.z), actf<ACT>(v.w)};
    if (ACT == 2) asm volatile("s_nop 1" : "+v"(r));
    return r; }
template <int ACT> __device__ __forceinline__ void store_tile_bf16(AccRef acc, bf16* base, int ld, int row0, int col0) {
#pragma unroll
    for (int ai = 0; ai < 2; ++ai)
#pragma unroll
        for (int m = 0; m < 4; ++m) { const unsigned ob = ((unsigned)(row0 + ai * 128 + m * 16) * (unsigned)ld + (unsigned)col0) * 2u;
#pragma unroll
            for (int bj = 0; bj < 2; ++bj) *(v4u*)((char*)base + ob + bj * 256) = pack_f4(act4<ACT>(acc[ai][bj][m][0]), act4<ACT>(acc[ai][bj][m][1])); }
}
template <int ACT> __device__ __forceinline__ void store_tile_acc(AccRef acc, char* base, unsigned soff) {
    unsigned sbj = 8192u; asm volatile("" : "+s"(sbj)); const unsigned sm = sbj * 2u, sai = sbj * 8u;
#pragma unroll
    for (int ai = 0; ai < 2; ++ai)
#pragma unroll
        for (int m = 0; m < 4; ++m) { const unsigned ob = soff + (unsigned)ai * sai + (unsigned)m * sm;
#pragma unroll
            for (int bj = 0; bj < 2; ++bj) __builtin_nontemporal_store(pack_f4(act4<ACT>(acc[ai][bj][m][0]), act4<ACT>(acc[ai][bj][m][1])), (v4u*)(base + ob + (unsigned)bj * sbj)); }
}
#ifndef MOE1_PRE
#define MOE1_PRE 0
#endif
#ifndef EPI_OUT_PRE
#define EPI_OUT_PRE 1
#endif
#ifndef EPI_PRE
#define EPI_PRE 1
#endif
struct EpiInProj {
    static constexpr bool PERM = true; static constexpr bool I8 = true; static constexpr int NSTORE = EPI_PRE ? 16 : 0;
    unsigned char* slots; const float* qn_g; const float* kn_g; const float* cosT; const float* sinT; const float* sa; const float* sb;
    __device__ __forceinline__ const float* sa_ptr(const GUnit& u) const { return sa + u.pm * 256; }
    __device__ __forceinline__ const float* sb_ptr(const GUnit& u) const { return sb + u.pn * 256; }
    __device__ __forceinline__ void operator()(AccRef acc, const GUnit& u, int wr, int wc, int fr, int fq) const {
        const int sec = u.pn >> 2, tcol = (u.pn & 3) * 256, row0 = u.pm * 256 + wr * 64 + fr, col0 = tcol + wc * 32 + 8 * fq;
        if (sec == 3 || sec == 4) {
            const float* gn = (sec == 3) ? qn_g : kn_g; const float osc = (sec == 3) ? attn128::C2 : 1.0f;
            bf16* base = (bf16*)(slots + (size_t)(sec == 3 ? S_Q : S_K) * SLOT); const int colq = tcol + wc * 64 + 8 * fq;
            f32x4 gA[2], gB[2];
#pragma unroll
            for (int n = 0; n < 2; ++n) { gA[n] = *(const f32x4*)(gn + 8 * fq + 4 * n) * osc; gB[n] = *(const f32x4*)(gn + 32 + 8 * fq + 4 * n) * osc; }
            f32x4 Ct[2][2], St[2][2];
#define QK_LOAD(g, buf) do { const int row_ = row0 + ((g) >> 2) * 128 + ((g) & 3) * 16; _Pragma("unroll") for (int n = 0; n < 2; ++n) { const unsigned tb = ((unsigned)row_ * 64u + 16u * n + 4u * fq) * 4u; \
                Ct[buf][n] = *(const f32x4*)((const char*)cosT + tb); St[buf][n] = *(const f32x4*)((const char*)cosT + tb + 128u); } } while (0)
            QK_LOAD(0, 0);
#pragma unroll
            for (int g = 0; g < 8; ++g) { const int ai = g >> 2, m = g & 3, row = row0 + ai * 128 + m * 16;
                if (g < 7) QK_LOAD(g + 1, (g + 1) & 1);
                float ss = 0.f;
#pragma unroll
                for (int bj = 0; bj < 2; ++bj)
#pragma unroll
                    for (int n = 0; n < 2; ++n) { const f32x4 x = acc[ai][bj][m][n]; ss += (x.x * x.x + x.y * x.y) + (x.z * x.z + x.w * x.w); }
                { const int ln = fq * 16 + fr; ss += shx(ss, ln, 16); ss += shx(ss, ln, 32); }
                const float rs = 1.0f / sqrtf(ss * (1.0f / 64.0f) + EPSN);
                f32x4 o1[2], o2[2];
#pragma unroll
                for (int n = 0; n < 2; ++n) { const f32x4 c = Ct[g & 1][n], sn = St[g & 1][n];
                    const f32x4 x1 = acc[ai][0][m][n] * rs * gA[n], x2 = acc[ai][1][m][n] * rs * gB[n];
                    o1[n] = x1 * c - x2 * sn; o2[n] = x2 * c + x1 * sn; }
                const unsigned ob = ((unsigned)row * DM + (unsigned)colq) * 2u;
                *(v4u*)((char*)base + ob) = pack_f4(o1[0], o1[1]); *(v4u*)((char*)base + ob + 64) = pack_f4(o2[0], o2[1]); }
#undef QK_LOAD
        } else if (sec == 1) { store_tile_bf16<1>(acc, (bf16*)(slots + (size_t)S_Y * SLOT), DM, row0, col0); }
        else if (sec >= 6) { store_tile_acc<2>(acc, (char*)(slots + (size_t)(S_G0 + sec - 6) * SLOT), (unsigned)(u.pm * 4 + (u.pn & 3)) * 131072u + (unsigned)((wr * 4 + wc) * 64 + fq * 16 + fr) * 16u); }
        else { const int sl = (sec == 0) ? S_XLRU : (sec == 2 ? S_Z : S_V); store_tile_bf16<0>(acc, (bf16*)(slots + (size_t)sl * SLOT), DM, row0, col0); }
    }
};
__device__ __forceinline__ float logsigmoid8(float L) {
    const float e = __expf(-fabsf(L));
    const float l1p = (e < 0.1f) ? e * (1.0f - e * (0.5f - e * ((1.0f / 3.0f) - e * 0.25f))) : __logf(1.0f + e);
    return 8.0f * (fminf(L, 0.0f) - l1p);
}
struct EpiLruGates {
    static constexpr bool PERM = true; static constexpr bool I8 = false; static constexpr int NSTORE = EPI_PRE ? 16 : 0;
    unsigned char* slots; const float* ba; const float* bx; const float* ll;
    __device__ __forceinline__ void operator()(AccRef acc, const GUnit& u, int wr, int wc, int fr, int fq) const {
        const int ch0 = u.pn * 128 + wc * 32 + 8 * fq, row0 = u.pm * 256 + wr * 64 + fr;
        const bf16* xc = (const bf16*)(slots + (size_t)S_XC * SLOT); bf16* la = (bf16*)(slots + (size_t)S_LA * SLOT); bf16* v2 = (bf16*)(slots + (size_t)S_V2 * SLOT);
        f32x4 Lc[2], bav[2], bxv[2];
#pragma unroll
        for (int n = 0; n < 2; ++n) { const f32x4 lv = *(const f32x4*)(ll + ch0 + 4 * n); Lc[n] = (f32x4){logsigmoid8(lv.x), logsigmoid8(lv.y), logsigmoid8(lv.z), logsigmoid8(lv.w)};
            bav[n] = *(const f32x4*)(ba + ch0 + 4 * n); bxv[n] = *(const f32x4*)(bx + ch0 + 4 * n); }
        v4u xw8[8];
#pragma unroll
        for (int g = 0; g < 8; ++g) xw8[g] = *(const v4u*)((const char*)xc + ((unsigned)(row0 + (g >> 2) * 128 + (g & 3) * 16) * DM + (unsigned)ch0) * 2u);
#pragma unroll
        for (int ai = 0; ai < 2; ++ai)
#pragma unroll
            for (int m = 0; m < 4; ++m) { const unsigned off = ((unsigned)(row0 + ai * 128 + m * 16) * DM + (unsigned)ch0) * 2u;
                const v4u xw = xw8[ai * 4 + m];
                const f32x4 x0 = (f32x4){bflo(xw.x), bfhi(xw.x), bflo(xw.y), bfhi(xw.y)}, x1 = (f32x4){bflo(xw.z), bfhi(xw.z), bflo(xw.w), bfhi(xw.w)};
                const f32x4 a0 = act4<2>(acc[ai][0][m][0] + bav[0]) * Lc[0], a1 = act4<2>(acc[ai][0][m][1] + bav[1]) * Lc[1];
                const f32x4 g0 = act4<2>(acc[ai][1][m][0] + bxv[0]) * x0, g1 = act4<2>(acc[ai][1][m][1] + bxv[1]) * x1;
                *(v4u*)((char*)la + off) = pack_f4(a0, a1); *(v4u*)((char*)v2 + off) = pack_f4(g0, g1); }
    }
};
struct EpiMerge {
    static constexpr bool PERM = true; static constexpr bool I8 = false; static constexpr int NSTORE = EPI_PRE ? 16 : 0;
    unsigned char* slots; unsigned wgoff;
    template <bool PREV, bool LAST> __device__ __forceinline__ void run(AccRef acc, const bf16* gate, bf16* mg, unsigned offb, char* scr, unsigned soff, unsigned goff) const {
        v4u G[2][4], Q[2][4]; unsigned gs_ = 8192u; asm volatile("" : "+s"(gs_));
#define MG_OFF(g) (offb + (unsigned)((((g) >> 3) * 128 + (((g) >> 1) & 3) * 16) * DM + ((g) & 1) * 128) * 2u)
#define MG_SOFF(g) (soff + (unsigned)(g) * 1024u)
#define MG_GOFF(g) (goff + (unsigned)(g) * gs_)
#define MG_LOAD(b, buf) do { _Pragma("unroll") for (int k = 0; k < 4; ++k) { G[buf][k] = *(const v4u*)((const char*)gate + MG_GOFF(4 * (b) + k)); \
            if (PREV) Q[buf][k] = __builtin_nontemporal_load((const v4u*)(scr + MG_SOFF(4 * (b) + k))); } } while (0)
        MG_LOAD(0, 0);
#pragma unroll
        for (int b = 0; b < 4; ++b) {
            if (b < 3) MG_LOAD(b + 1, (b + 1) & 1);
#pragma unroll
            for (int k = 0; k < 4; ++k) { const int g = 4 * b + k, ai = g >> 3, m = (g >> 1) & 3, bj = g & 1; const v4u gw = G[b & 1][k];
                f32x4 o0 = (f32x4){bflo(gw.x), bfhi(gw.x), bflo(gw.y), bfhi(gw.y)} * acc[ai][bj][m][0], o1 = (f32x4){bflo(gw.z), bfhi(gw.z), bflo(gw.w), bfhi(gw.w)} * acc[ai][bj][m][1];
                if (PREV) { const v4u pw = Q[b & 1][k]; o0 += (f32x4){bflo(pw.x), bfhi(pw.x), bflo(pw.y), bfhi(pw.y)}; o1 += (f32x4){bflo(pw.z), bfhi(pw.z), bflo(pw.w), bfhi(pw.w)}; }
                if (LAST) *(v4u*)((char*)mg + MG_OFF(g)) = pack_f4(o0, o1); else *(v4u*)(scr + MG_SOFF(g)) = pack_f4(o0, o1); }
        }
#undef MG_LOAD
#undef MG_SOFF
#undef MG_GOFF
#undef MG_OFF
    }
    __device__ __forceinline__ void operator()(AccRef acc, const GUnit& u, int wr, int wc, int fr, int fq) const {
        const int row0 = u.pm * 256 + wr * 64 + fr, col0 = u.pn * 256 + wc * 32 + 8 * fq; const int i = u.aux;
        const bf16* gate = (const bf16*)(slots + (size_t)(S_G0 + i) * SLOT); bf16* mg = (bf16*)(slots + (size_t)S_MERGED * SLOT);
        char* scr = (char*)(slots + (size_t)S_XLRU * SLOT) + wgoff;
        const unsigned offb = ((unsigned)row0 * DM + (unsigned)col0) * 2u, soff = (unsigned)(((wr * 4 + wc) * 16) * 64 + fq * 16 + fr) * 16u;
        const unsigned goff = (unsigned)(u.pm * 4 + u.pn) * 131072u + (unsigned)((wr * 4 + wc) * 64 + fq * 16 + fr) * 16u;
        if (i == 0) run<false, false>(acc, gate, mg, offb, scr, soff, goff); else if (i == 1) run<true, false>(acc, gate, mg, offb, scr, soff, goff); else run<true, true>(acc, gate, mg, offb, scr, soff, goff);
    }
};
struct EpiOut {
    static constexpr bool PERM = true; static constexpr bool I8 = false; static constexpr int NSTORE = EPI_OUT_PRE ? 16 : 0;
    const void* xsrc; bf16* xb; const float* g1; int rowoff; bool srcf32;
    template <bool F32> __device__ __forceinline__ void run(AccRef acc, unsigned e0, const f32x4 (&gv)[2][2]) const {
        v4u X[2][4], Y[2][4];
#define XO_E(g) (e0 + (unsigned)((((g) >> 3) * 128 + (((g) >> 1) & 3) * 16) * DM + ((g) & 1) * 128))
#define XO_LOAD(b, buf) do { _Pragma("unroll") for (int k = 0; k < 4; ++k) { const unsigned e_ = XO_E(4 * (b) + k); \
            if (F32) { X[buf][k] = *(const v4u*)((const char*)xsrc + e_ * 4u); Y[buf][k] = *(const v4u*)((const char*)xsrc + e_ * 4u + 16); } else X[buf][k] = *(const v4u*)((const char*)xsrc + e_ * 2u); } } while (0)
        XO_LOAD(0, 0);
#pragma unroll
        for (int b = 0; b < 4; ++b) {
            if (b < 3) XO_LOAD(b + 1, (b + 1) & 1);
#pragma unroll
            for (int k = 0; k < 4; ++k) { const int g = 4 * b + k, ai = g >> 3, m = (g >> 1) & 3, bj = g & 1; const v4u w = X[b & 1][k];
                f32x4 x0, x1;
                if (F32) { x0 = __builtin_bit_cast(f32x4, w); x1 = __builtin_bit_cast(f32x4, Y[b & 1][k]); }
                else { x0 = (f32x4){bflo(w.x), bfhi(w.x), bflo(w.y), bfhi(w.y)}; x1 = (f32x4){bflo(w.z), bfhi(w.z), bflo(w.w), bfhi(w.w)}; }
                const f32x4 o0 = x0 + gv[bj][0] * acc[ai][bj][m][0], o1 = x1 + gv[bj][1] * acc[ai][bj][m][1];
                *(v4u*)((char*)xb + XO_E(g) * 2u) = pack_f4(o0, o1); }
        }
#undef XO_LOAD
#undef XO_E
    }
    __device__ __forceinline__ void operator()(AccRef acc, const GUnit& u, int wr, int wc, int fr, int fq) const {
        const int row0 = rowoff + u.pm * 256 + wr * 64 + fr, col0 = u.pn * 256 + wc * 32 + 8 * fq;
        f32x4 gv[2][2];
#pragma unroll
        for (int bj = 0; bj < 2; ++bj) { gv[bj][0] = *(const f32x4*)(g1 + col0 + bj * 128); gv[bj][1] = *(const f32x4*)(g1 + col0 + bj * 128 + 4); }
        const unsigned e0 = (unsigned)row0 * DM + (unsigned)col0;
        if (srcf32) run<true>(acc, e0, gv); else run<false>(acc, e0, gv);
    }
};
struct EpiMoe1 {
    static constexpr bool PERM = true; static constexpr bool I8 = true; static constexpr int NSTORE = MOE1_PRE ? 8 : 0;
    bf16* act; const float* wtab; const float* stab; const float* sbm;
    __device__ __forceinline__ const float* sa_ptr(const GUnit& u) const { return stab + (size_t)u.aux * NTOK + u.aux2 * 256; }
    __device__ __forceinline__ const float* sb_ptr(const GUnit& u) const { return sbm + u.aux * 1024 + u.pn * 256; }
    __device__ __forceinline__ void operator()(AccRef acc, const GUnit& u, int wr, int wc, int fr, int fq) const {
        const int row0 = u.pm * 256 + wr * 64 + fr, col0 = u.pn * 128 + wc * 32 + 8 * fq;
#ifndef MOE1_SERIAL
        float w8[8];
#pragma unroll
        for (int g = 0; g < 8; ++g) w8[g] = *(const float*)((const char*)wtab + ((unsigned)u.aux * NTOK + (unsigned)(u.aux2 * 256 + (wr * 64 + fr + (g >> 2) * 128 + (g & 3) * 16))) * 4u);
#endif
#pragma unroll
        for (int ai = 0; ai < 2; ++ai)
#pragma unroll
#ifdef MOE1_SERIAL
            for (int m = 0; m < 4; ++m) { const int row = row0 + ai * 128 + m * 16; const float w = *(const float*)((const char*)wtab + ((unsigned)u.aux * NTOK + (unsigned)(u.aux2 * 256 + (row - u.pm * 256))) * 4u);
#else
            for (int m = 0; m < 4; ++m) { const int row = row0 + ai * 128 + m * 16; const float w = w8[ai * 4 + m];
#endif
                const f32x4 g0 = acc[ai][0][m][0], g1 = acc[ai][0][m][1];
                const f32x4 o0 = g0 * act4<2>(g0) * acc[ai][1][m][0] * w, o1 = g1 * act4<2>(g1) * acc[ai][1][m][1] * w;
                *(v4u*)((char*)act + ((unsigned)row * DEXP + (unsigned)col0) * 2u) = pack_f4(o0, o1); }
    }
};
struct EpiMoe2 {
    static constexpr bool PERM = true; static constexpr bool I8 = false; static constexpr int NSTORE = EPI_PRE ? 16 : 0;
    bf16* y;
    __device__ __forceinline__ void operator()(AccRef acc, const GUnit& u, int wr, int wc, int fr, int fq) const {
        store_tile_bf16<0>(acc, y, DM, u.pm * 256 + wr * 64 + fr, u.pn * 256 + wc * 32 + 8 * fq);
    }
};
struct SchedTiles { static constexpr bool GATHER = false;
    const char* A; const char* B; size_t astep, bstep, acol; int nM, nN, G, c;
    __device__ __forceinline__ bool next(int i, GUnit& u) const { int pm, pn; if (!pg8::static_tile(i, G, c, nM, nN, pm, pn)) return false;
        u.pm = pm; u.pn = pn; u.aux = 0; u.A = A + (size_t)pm * astep + (size_t)pn * acol; u.B = B + (size_t)pn * bstep; return true; }
};
struct SchedMerge { static constexpr bool GATHER = false;
    unsigned char* slots; const char* B; int G, c;
    __device__ __forceinline__ bool next(int j, GUnit& u) const { int pm, pn; const int r = j / 3, i = j - 3 * r; if (!pg8::static_tile(r, G, c, SEQ / 256, DM / 256, pm, pn)) return false;
        const int sl = (i == 0) ? S_Y : (i == 1 ? S_BRPOOL : S_O0);
        u.pm = pm; u.pn = pn; u.aux = i; u.A = (const char*)slots + (size_t)sl * SLOT + (size_t)pm * 256 * DM * 2; u.B = B + ((size_t)i * DM + pn * 256) * DM * 2; return true; }
};
template <bool GATHER_> struct SchedMoe { static constexpr bool GATHER = GATHER_;
    const char* A; const char* B; size_t astep, bstep_e, bstep_n; const LAS int* tcum; const int* inv; int G, c, tid;
    __device__ __forceinline__ bool next(int i, GUnit& u) const {
        const int ntile = __builtin_amdgcn_readfirstlane(tcum[16]), nwg = ntile * 4; const long L = (long)i * G + c; if (L >= nwg) return false;
        int id = (int)L; { const int q = nwg / 8, r = nwg % 8, xcd = id % 8, off = id / 8; id = (xcd < r ? xcd * (q + 1) : r * (q + 1) + (xcd - r) * q) + off; }
        const int rt = id >> 2, tn = id & 3; int e = 0;
#pragma unroll
        for (int k = 1; k < 16; ++k) e += (rt >= __builtin_amdgcn_readfirstlane(tcum[k])) ? 1 : 0;
        const int tm = rt - __builtin_amdgcn_readfirstlane(tcum[e]);
        u.pm = rt; u.pn = tn; u.aux = e; u.aux2 = tm; u.B = B + (size_t)e * bstep_e + (size_t)tn * bstep_n;
        if constexpr (GATHER) {
            u.A = A; const int cnt = __builtin_amdgcn_readfirstlane(tcum[32 + e]);
#pragma unroll
            for (int q = 0; q < 2; ++q) { int R, C; pg8::stage_rc(tid * 16 + q * 8192, R, C);
                const int p0 = tm * 256 + R, p1 = p0 + 128;
                const unsigned ib = ((unsigned)e * NTOK + (unsigned)p0) * 4u;
                const int t0 = *(const int*)((const char*)inv + (p0 < cnt ? ib : (unsigned)e * NTOK * 4u)), t1 = *(const int*)((const char*)inv + (p1 < cnt ? ib + 512u : (unsigned)e * NTOK * 4u));
                u.va0[q] = (unsigned)(t0 * DM + C * 2); u.va1[q] = (unsigned)(t1 * DM + C * 2); }
        } else u.A = A + (size_t)rt * astep;
        return true; }
};

__device__ __forceinline__ void moe_table(const Frame& F, int l) {
    LAS int* tcum = (LAS int*)(F.lds + LDSCTL_OFF);
    __syncthreads();
    if (F.tid == 0) { int cum = 0;
        for (int e = 0; e < NEXP; ++e) { const int c = (int)__hip_atomic_load((unsigned*)(F.ctl + CW_EXPCNT + (l * 16 + e) * 64), RLX_AGENT); tcum[e] = cum; tcum[32 + e] = c; cum += (c + 255) >> 8; }
        tcum[16] = cum; }
    __syncthreads();
}
__device__ __forceinline__ float sel4(int i, float a, float b, float c, float d) { return i == 0 ? a : (i == 1 ? b : (i == 2 ? c : d)); }
__device__ __forceinline__ void router_phase(const Frame& F, KArgs ap, int l) {
    LAS float* rwT = (LAS float*)(F.lds + RING_OFF);
    LAS int* wcnt = (LAS int*)(F.lds + RING_OFF + 65536);
    LAS int* wbase = wcnt + 128;
    __syncthreads();
    for (int i = F.tid; i < DM * NEXP; i += NWAVES * 64) rwT[(i & 15) * DM + (i >> 4)] = gin(ap, I_RW)[i];
    __syncthreads();
    const float* mod = (const float*)(F.ws + WS_MOD); const bf16* xin = (const bf16*)(F.ws + WS_XB); unsigned char* xn = F.ws + MOE_XN; float* xsa = (float*)(F.ws + WS_XSA); float* stab = (float*)(F.ws + WS_STAB);
    float rb[16];
#pragma unroll
    for (int e = 0; e < 16; ++e) rb[e] = gin(ap, I_RB)[e];
    int2* tok_e = (int2*)(F.ws + WS_TOKE); int2* tok_p = (int2*)(F.ws + WS_TOKP); int* inv = (int*)(F.ws + WS_INV); float* wtab = (float*)(F.ws + WS_WTAB);
    int elane[16];
    { float tg[16];
#pragma unroll
      for (int e = 0; e < 16; ++e) { tg[e] = (float)e; asm volatile("" : "+v"(tg[e])); }
      const int mine = (int)(red16(tg) * (1.0f / 64.0f) + 0.5f);
#pragma unroll
      for (int e = 0; e < 16; ++e) { const unsigned long long m = __ballot(mine == e); elane[e] = (int)__builtin_ctzll(m | (1ull << 63)); } }
    for (int blk = F.bid; blk < NTOK / 128; blk += F.G) {
        const int rbase = blk * 128 + F.wave * 16, b = (blk * 128) / SEQ;
        const float* sh = mod + ((size_t)l * NB + b) * 6 * DM + 3 * DM; const float* sc = sh + DM; const float* g = gin(ap, I_N2G) + (size_t)l * DM;
        f32x4 mul[4], add[4];
#pragma unroll
        for (int j = 0; j < 4; ++j) { const int c = 4 * F.lane + 256 * j; mul[j] = *(const f32x4*)(g + c) * (*(const f32x4*)(sc + c) + 1.0f); add[j] = *(const f32x4*)(sh + c); }
        int cnt = 0, me0 = 0, me1 = 0, ml0 = 0, ml1 = 0; float mw0 = 0.f, mw1 = 0.f, msc = 0.f;
        v2u nv[4];
        { const v2u* xr = (const v2u*)(xin + (size_t)rbase * DM) + F.lane;
#pragma unroll
          for (int j = 0; j < 4; ++j) nv[j] = xr[64 * j]; }
#pragma nounroll
        for (int r = 0; r < 16; ++r) {
            const int row = rbase + r;
            f32x4 v[4]; float s = 0.f;
#pragma unroll
            for (int j = 0; j < 4; ++j) { v[j] = (f32x4){bflo(nv[j].x), bfhi(nv[j].x), bflo(nv[j].y), bfhi(nv[j].y)}; s += (v[j].x * v[j].x + v[j].y * v[j].y) + (v[j].z * v[j].z + v[j].w * v[j].w); }
            { const v2u* xr = (const v2u*)(xin + (size_t)(r < 15 ? row + 1 : row) * DM) + F.lane;
#pragma unroll
              for (int j = 0; j < 4; ++j) nv[j] = xr[64 * j]; }
            const float rs = 1.0f / sqrtf(wave_sum(s, F.lane) * (1.0f / DM) + EPSN);
#pragma unroll
            for (int j = 0; j < 4; ++j) v[j] = v[j] * rs * mul[j] + add[j];
            const float rsc = quant_row_store(v, F.lane, xn + (size_t)row * DM, xsa + row);
            float lg[16], tp[16];
#pragma unroll
            for (int e = 0; e < 16; ++e) { float t = 0.f;
#pragma unroll
                for (int j = 0; j < 4; ++j) { const f32x4 w4 = *(const LAS f32x4*)(rwT + e * DM + 256 * j + 4 * F.lane); t += (v[j].x * w4.x + v[j].y * w4.y) + (v[j].z * w4.z + v[j].w * w4.w); }
                tp[e] = t; asm volatile("" ::: "memory"); }
            { const float tot = red16(tp);
#pragma unroll
              for (int e = 0; e < 16; ++e) lg[e] = __uint_as_float((unsigned)__builtin_amdgcn_readlane((int)__float_as_uint(tot), elane[e])); }
            float best = -INFINITY, A0 = 0.f, A1 = 0.f; int e0 = 0, e1 = 1;
#pragma unroll
            for (int gI = 0; gI < 4; ++gI) {
                float af[4], sl[4];
#pragma unroll
                for (int k = 0; k < 4; ++k) { af[k] = 1.0f / (1.0f + __expf(-lg[4 * gI + k])); sl[k] = af[k] + rb[4 * gI + k]; }
                int i1 = 0; float m1 = sl[0];
#pragma unroll
                for (int k = 1; k < 4; ++k) if (sl[k] > m1) { m1 = sl[k]; i1 = k; }
                int i2 = 0; float m2 = -INFINITY;
#pragma unroll
                for (int k = 0; k < 4; ++k) if (k != i1 && sl[k] > m2) { m2 = sl[k]; i2 = k; }
                const float gs = m1 + m2;
                if (gs > best) { best = gs; e0 = 4 * gI + i1; e1 = 4 * gI + i2; A0 = sel4(i1, af[0], af[1], af[2], af[3]); A1 = sel4(i2, af[0], af[1], af[2], af[3]); }
            }
            const float inv = 1.0f / (A0 + A1);
            const int l0 = shi(cnt, e0), l1 = shi(cnt, e1);
            cnt += (F.lane == e0 ? 1 : 0) + (F.lane == e1 ? 1 : 0);
            if (F.lane == r) { me0 = e0; me1 = e1; ml0 = l0; ml1 = l1; mw0 = A0 * inv; mw1 = A1 * inv; msc = rsc; }
        }
        if (F.lane < 16) wcnt[F.wave * 16 + F.lane] = cnt;
        __syncthreads();
        if (F.tid < 16) { int c8[8], tot = 0;
#pragma unroll
            for (int w = 0; w < 8; ++w) { c8[w] = wcnt[w * 16 + F.tid]; tot += c8[w]; }
            int base = (int)__hip_atomic_fetch_add((unsigned*)(F.ctl + CW_EXPCNT + (l * 16 + F.tid) * 64), (unsigned)tot, RLX_AGENT);
#pragma unroll
            for (int w = 0; w < 8; ++w) { wbase[w * 16 + F.tid] = base; base += c8[w]; } }
        __syncthreads();
        if (F.lane < 16) { const int row = rbase + F.lane, q0 = wbase[F.wave * 16 + me0] + ml0, q1 = wbase[F.wave * 16 + me1] + ml1;
            tok_e[row] = make_int2(me0, me1); tok_p[row] = make_int2(q0, q1);
            inv[(size_t)me0 * NTOK + q0] = row; inv[(size_t)me1 * NTOK + q1] = row; wtab[(size_t)me0 * NTOK + q0] = mw0; wtab[(size_t)me1 * NTOK + q1] = mw1;
            stab[(size_t)me0 * NTOK + q0] = msc; stab[(size_t)me1 * NTOK + q1] = msc; }
        __syncthreads();
    }
}
__device__ __forceinline__ void moe_combine_phase(const Frame& F, KArgs ap, int l) {
    const int nl = l + 1; const bool has_nl = nl < NLAYER;
    f32x4 nmul[4], nadd[4];
    if (has_nl) { const float* g = gin(ap, I_N1G) + (size_t)nl * DM; const float* sh = (const float*)(F.ws + WS_MOD) + ((size_t)nl * NB + 0) * 6 * DM; const float* sc = sh + DM;
#pragma unroll
        for (int j = 0; j < 4; ++j) { const int c = 4 * F.lane + 256 * j; nmul[j] = *(const f32x4*)(g + c) * (*(const f32x4*)(sc + c) + 1.0f); nadd[j] = *(const f32x4*)(sh + c); } }
    unsigned char* xn0 = F.ws + WS_SLOTS + (size_t)S_XN * SLOT; float* xs0 = (float*)(F.ws + WS_XS);
    moe_table(F, l);
    const LAS int* tcum = (const LAS int*)(F.lds + LDSCTL_OFF);
    const int2* tok_e = (const int2*)(F.ws + WS_TOKE); const int2* tok_p = (const int2*)(F.ws + WS_TOKP);
    const bf16* y = (const bf16*)(F.ws + MOE_AG); const float* mod = (const float*)(F.ws + WS_MOD); bf16* xb = (bf16*)(F.ws + WS_XB);
    const int gw = F.vcu * NWAVES + F.wave, NGW = F.G * NWAVES;
    constexpr int TQ = 4;
    for (int t0 = gw; t0 < NTOK; t0 += TQ * NGW) {
        f32x4 xv[TQ][4]; v2u xw[TQ][4], u0[TQ][4], u1[TQ][4];
#pragma unroll
        for (int q = 0; q < TQ; ++q) { const int t = (t0 + q * NGW < NTOK) ? t0 + q * NGW : t0; const int2 e = tok_e[t], p = tok_p[t];
            const int s0 = tcum[e.x] * 256 + p.x, s1 = tcum[e.y] * 256 + p.y;
            const v2u* xr = (const v2u*)(xb + (size_t)t * DM) + F.lane;
            const v2u* y0 = (const v2u*)(y + (size_t)s0 * DM) + F.lane; const v2u* y1 = (const v2u*)(y + (size_t)s1 * DM) + F.lane;
#pragma unroll
            for (int j = 0; j < 4; ++j) { xw[q][j] = xr[64 * j]; u0[q][j] = y0[64 * j]; u1[q][j] = y1[64 * j]; } }
#pragma unroll
        for (int q = 0; q < TQ; ++q) { const int t = t0 + q * NGW; if (t < NTOK) {
            const float* g2 = mod + ((size_t)l * NB + t / SEQ) * 6 * DM + 5 * DM;
            f32x4* xo = (f32x4*)(gout(ap) + (size_t)t * DM) + F.lane; v2u* xr = (v2u*)(xb + (size_t)t * DM) + F.lane;
#pragma unroll
            for (int j = 0; j < 4; ++j) { const f32x4 gv = *(const f32x4*)(g2 + 4 * F.lane + 256 * j); xv[q][j] = (f32x4){bflo(xw[q][j].x), bfhi(xw[q][j].x), bflo(xw[q][j].y), bfhi(xw[q][j].y)};
                const f32x4 yy = (f32x4){bflo(u0[q][j].x) + bflo(u1[q][j].x), bfhi(u0[q][j].x) + bfhi(u1[q][j].x), bflo(u0[q][j].y) + bflo(u1[q][j].y), bfhi(u0[q][j].y) + bfhi(u1[q][j].y)};
                xv[q][j] = xv[q][j] + gv * yy; if (has_nl) xr[64 * j] = (v2u){pk2(xv[q][j].x, xv[q][j].y), pk2(xv[q][j].z, xv[q][j].w)}; else __builtin_nontemporal_store(xv[q][j], &xo[64 * j]); }
            if (has_nl && t < SEQ) { float s = 0.f;
#pragma unroll
                for (int j = 0; j < 4; ++j) s += (xv[q][j].x * xv[q][j].x + xv[q][j].y * xv[q][j].y) + (xv[q][j].z * xv[q][j].z + xv[q][j].w * xv[q][j].w);
                const float rs = 1.0f / sqrtf(wave_sum(s, F.lane) * (1.0f / DM) + EPSN);
                f32x4 yv[4];
#pragma unroll
                for (int j = 0; j < 4; ++j) yv[j] = xv[q][j] * rs * nmul[j] + nadd[j];
                quant_row_store(yv, F.lane, xn0 + (size_t)t * DM, xs0 + t); } } }
    }
}
__device__ __forceinline__ void attention_phase(const Frame& F, KArgs ap, int l, unsigned char* slots, char* shm) {
    const attn128::bf16* Q = (const attn128::bf16*)(slots + (size_t)S_Q * SLOT); const attn128::bf16* K = (const attn128::bf16*)(slots + (size_t)S_K * SLOT);
    const attn128::bf16* V = (const attn128::bf16*)(slots + (size_t)S_V * SLOT); attn128::bf16* O0 = (attn128::bf16*)(slots + (size_t)S_O0 * SLOT);
    const float lam_init = (l == 0) ? 0.2f : 0.35550907f;
    const float d1 = wave_sum(gin(ap, I_LQ1)[l * 64 + F.lane] * gin(ap, I_LK1)[l * 64 + F.lane], F.lane), d2 = wave_sum(gin(ap, I_LQ2)[l * 64 + F.lane] * gin(ap, I_LK2)[l * 64 + F.lane], F.lane);
    const float lam = __uint_as_float((unsigned)__builtin_amdgcn_readfirstlane((int)__float_as_uint(__expf(d1) - __expf(d2) + lam_init)));
    float* gsc = (float*)(F.ws + WS_GSC);
    if (F.tid < 128) gsc[F.tid] = gin(ap, I_SUBLN)[l * 128 + F.tid] * (1.0f - lam_init);
    VM_WAIT(); __syncthreads();
    if (F.wave >= 4) __builtin_amdgcn_s_setprio(1);
    for (int j = 0;; ++j) {
        const int p = (j >> 2) * F.G + F.vcu; if (p >= 256) break;
        const int h = p >> 5, s = p & 31, c = (j >> 1) & 1, qb = (j & 1) ? 63 - s : s, hq = 2 * h + c;
        int tid_u = F.tid; asm volatile("" : "+v"(tid_u)); __builtin_assume((unsigned)tid_u < 512u);
        if (c == 0) attn128::attn_unit128<8, 0>(qb, Q + hq * 64, K + hq * 64, V + h * 128, O0 + h * 128, shm, tid_u, lam, gsc);
        else        attn128::attn_unit128<8, 1>(qb, Q + hq * 64, K + hq * 64, V + h * 128, O0 + h * 128, shm, tid_u, lam, gsc);
    }
    __builtin_amdgcn_s_setprio(0);
}

#ifndef SCAN_LB
#define SCAN_LB 1
#endif
constexpr int PHA = SCAN_LB ? 4 : 5;
constexpr int PH_PER_BATCH = PHA + 3, PH_MOE = 4, PH_PER_LAYER = 2 * PH_PER_BATCH + PH_MOE, N_PHASES = 1 + NLAYER * PH_PER_LAYER;
#ifndef ONLY_KIND
#define ONLY_KIND -1
#endif
#define KON(kind) (ONLY_KIND < 0 || ONLY_KIND == (kind))
#ifdef REP_KIND
#define RLOOP(k) for (int rep_ = 0, repn_ = ((REP_KIND == (k)) ? REP_N : 1); rep_ < repn_; ++rep_)
#else
#define RLOOP(k)
#endif
__global__ void __launch_bounds__(NWAVES * 64, 2) mk_fwd(Args args_in_kernarg_segment) {
    extern __shared__ __attribute__((aligned(16))) unsigned char lds[];
    Frame F0;
    F0.lds = (LAS unsigned char*)lds; F0.ldsg = lds;
    F0.tid = threadIdx.x; F0.lane = F0.tid & 63; F0.wave = __builtin_amdgcn_readfirstlane(F0.tid >> 6);
    F0.G = gridDim.x; F0.bid = blockIdx.x; { const int bx = blockIdx.x; F0.vcu = (F0.G % 8 == 0) ? (bx % 8) * (F0.G / 8) + bx / 8 : bx; }
    int lo, hi;
    { KArgs A = kargs(); F0.ws = A->ws; lo = A->ph_lo; hi = A->ph_hi; }
    F0.ctl = (gu32*)(F0.ws + WS_CTL);
    volatile LAS unsigned* MISC = (volatile LAS unsigned*)(F0.lds + MISC_OFF);
    for (int u = F0.tid; u < (LDS_BYTES - LDSCTL_OFF) / 4; u += NWAVES * 64) ((LAS unsigned*)(F0.lds + LDSCTL_OFF))[u] = 0u;
    __syncthreads();
    XcdBarrier bar; bar.bar = (unsigned*)(F0.ctl + CW_BAR); bar.x = 0; bar.st = nullptr;
    if (hi - lo > 1) bar = xcd_barrier_post((unsigned*)(F0.ctl + CW_BAR), MISC + 8);
#define IN(k) (lo <= (k) && (k) < hi)
#define SEAM(k) do { if (IN(k) && IN((k) + 1)) { XcdBarrier bb_ = bar; bb_.bar = (unsigned*)(kargs()->ws + WS_CTL) + CW_BAR; asm volatile("" : "+s"(bb_.x)); xcd_barrier(bb_); } } while (0)
#define WL(l) (P.ws + WS_W + (size_t)(l) * W_LAYER)
#define MODB(l, b) ((const float*)(P.ws + WS_MOD) + ((size_t)(l) * NB + (b)) * 6 * DM)
#define SLOTS (P.ws + WS_SLOTS)
#define PFRAME() asm volatile("" : "+v"(F0.tid)); __builtin_assume((unsigned)F0.tid < 512u); asm volatile("" : "+s"(F0.G), "+s"(F0.vcu), "+s"(F0.bid)); Frame P = F0; P.ws = kargs()->ws; P.lane = P.tid & 63; P.wave = __builtin_amdgcn_readfirstlane(P.tid >> 6); P.ctl = (gu32*)(P.ws + WS_CTL)

    if (KON(0) && IN(0)) { PFRAME(); KArgs A = kargs(); ada_mod(P, A); fold_pool_weights(P, A); rope_tables(P); conv_mixer_weights(P, A); }
    SEAM(0);

    for (int l = 0; l < NLAYER; ++l) {
        for (int b = 0; b < NB; ++b) {
            const int p0 = 1 + l * PH_PER_LAYER + b * PH_PER_BATCH;
#define PFRAME_LB() PFRAME(); asm volatile("" : "+s"(l), "+s"(b))
            if (KON(1) && IN(p0 + 0) && l == 0 && b == 0) { PFRAME_LB(); KArgs A = kargs();
                norm_rows<false>(P, gin(A, I_X), gin(A, I_N1G), MODB(0, 0), MODB(0, 0) + DM, SLOTS + (size_t)S_XN * SLOT, (float*)(P.ws + WS_XS), SEQ);
                quant_pool_cols(P); }
            if (l == 0 && b == 0) SEAM(p0 + 0);
            if (KON(2) && IN(p0 + 1)) RLOOP(2) { PFRAME_LB(); KArgs A = kargs();
                SchedTiles S{(const char*)SLOTS + (size_t)S_XN * SLOT, (const char*)WL(l) + W_IN, (size_t)256 * DM, (size_t)256 * DM, 0, SEQ / 256, INW / 256, P.G, P.bid};
                EpiInProj E{SLOTS, gin(A, I_QNG) + l * 64, gin(A, I_KNG) + l * 64, (const float*)(P.ws + WS_COS), (const float*)(P.ws + WS_SIN), (const float*)(P.ws + WS_XS), (const float*)(WL(l) + W_SB)};
                pg8::gemm_phase<EpiInProj, SchedTiles>(P.lds + RING_OFF, P.tid, DM / 2, DM / 2, DM / 2, S, E);
            }
            SEAM(p0 + 1);
            if (KON(3) && IN(p0 + 2)) RLOOP(3) { PFRAME_LB(); KArgs A = kargs(); conv_pool_phase(P, A, l, SLOTS);
                if (b == 0) {
                    if (l == 0) norm_rows<false>(P, gin(A, I_X) + (size_t)SEQ * DM, gin(A, I_N1G), MODB(0, 1), MODB(0, 1) + DM, SLOTS + (size_t)S_XN * SLOT, (float*)(P.ws + WS_XS), SEQ);
                    else norm_rows<true>(P, (const bf16*)(P.ws + WS_XB) + (size_t)SEQ * DM, gin(A, I_N1G) + (size_t)l * DM, MODB(l, 1), MODB(l, 1) + DM, SLOTS + (size_t)S_XN * SLOT, (float*)(P.ws + WS_XS), SEQ); } }
            SEAM(p0 + 2);
            if (KON(4) && IN(p0 + 3)) RLOOP(4) { PFRAME_LB(); KArgs A = kargs();
                SchedTiles S{(const char*)SLOTS + (size_t)S_XC * SLOT, (const char*)WL(l) + W_LRU, (size_t)256 * DM * 2, (size_t)256 * 128 * 2, (size_t)128 * 2, SEQ / 256, 8, P.G, P.bid};
                EpiLruGates E{SLOTS, gin(A, I_LBA) + (size_t)l * DM, gin(A, I_LBX) + (size_t)l * DM, gin(A, I_LL) + (size_t)l * DM};
                int kk = 128; asm volatile("" : "+s"(kk));
                pg8::gemm_phase<EpiLruGates, SchedTiles>(P.lds + RING_OFF, P.tid, kk, DM, 128, S, E);
            }
            SEAM(p0 + 3);
#if SCAN_LB
            if (KON(6) && IN(p0 + 4)) { PFRAME_LB(); scan_lookback_phase(P, SLOTS, 2 * l + b); }
#else
            if (KON(5) && IN(p0 + 4)) RLOOP(5) { PFRAME_LB(); scan_phase<1>(P, SLOTS); }
            SEAM(p0 + 4);
            if (KON(6) && IN(p0 + 5)) RLOOP(6) { PFRAME_LB(); scan_phase<2>(P, SLOTS); }
#endif
            if (KON(7) && IN(p0 + PHA)) { PFRAME_LB(); KArgs A = kargs(); attention_phase(P, A, l, SLOTS, (char*)lds + RING_OFF); }
            SEAM(p0 + PHA);
            if (KON(9) && IN(p0 + PHA + 1)) RLOOP(9) { PFRAME_LB();
                SchedMerge S{SLOTS, (const char*)WL(l) + W_BR, P.G, P.bid}; EpiMerge E{SLOTS, (unsigned)P.bid * 131072u};
                pg8::gemm_phase<EpiMerge, SchedMerge>(P.lds + RING_OFF, P.tid, DM, DM, DM, S, E);
            }
            SEAM(p0 + PHA + 1);
            if (KON(10) && IN(p0 + PHA + 2)) { PFRAME_LB(); KArgs A = kargs(); const void* xsrc = (l == 0) ? (const void*)gin(A, I_X) : (const void*)(P.ws + WS_XB);
                SchedTiles S{(const char*)SLOTS + (size_t)S_MERGED * SLOT, (const char*)WL(l) + W_OUT, (size_t)256 * DM * 2, (size_t)256 * DM * 2, 0, SEQ / 256, DM / 256, P.G, P.bid};
                EpiOut E{xsrc, (bf16*)(P.ws + WS_XB), MODB(l, b) + 2 * DM, b * SEQ, l == 0};
                pg8::gemm_phase<EpiOut, SchedTiles>(P.lds + RING_OFF, P.tid, DM, DM, DM, S, E);
            }
            SEAM(p0 + PHA + 2);
        }
#define PFRAME_L() PFRAME(); asm volatile("" : "+s"(l))
        const int q0 = 1 + l * PH_PER_LAYER + 2 * PH_PER_BATCH;
        if (KON(11) && IN(q0 + 0)) {
#pragma nounroll
            for (int st_ = 0; st_ < 2; ++st_) { PFRAME_L(); KArgs A = kargs(); asm volatile("" : "+s"(st_)); if ((st_ ^ (P.vcu & 1)) == 0) conv_moe_weights(P, A, l); else router_phase(P, A, l); } }
        SEAM(q0 + 0);
        if (KON(13) && IN(q0 + 1)) RLOOP(13) { PFRAME_L();
            moe_table(P, l);
            SchedMoe<true> S{(const char*)P.ws + MOE_XN, (const char*)P.ws + MOE_WGU, 0, (size_t)1024 * DM, (size_t)256 * DM, (const LAS int*)(P.lds + LDSCTL_OFF), (const int*)(P.ws + WS_INV), P.G, P.bid, P.tid};
            EpiMoe1 E{(bf16*)(P.ws + MOE_ACT), (const float*)(P.ws + WS_WTAB), (const float*)(P.ws + WS_STAB), (const float*)(P.ws + MOE_SB)};
            pg8::gemm_phase<EpiMoe1, SchedMoe<true>>(P.lds + RING_OFF, P.tid, DM / 2, DM / 2, DM / 2, S, E);
        }
        SEAM(q0 + 1);
        if (KON(14) && IN(q0 + 2)) RLOOP(14) { PFRAME_L();
            moe_table(P, l);
            SchedMoe<false> S{(const char*)P.ws + MOE_ACT, (const char*)P.ws + MOE_WD, (size_t)256 * DEXP * 2, (size_t)1024 * DEXP * 2, (size_t)256 * DEXP * 2, (const LAS int*)(P.lds + LDSCTL_OFF), nullptr, P.G, P.bid, P.tid};
            EpiMoe2 E{(bf16*)(P.ws + MOE_AG)};
            pg8::gemm_phase<EpiMoe2, SchedMoe<false>>(P.lds + RING_OFF, P.tid, DEXP, DEXP, DEXP, S, E);
        }
        SEAM(q0 + 2);
        if (KON(15) && IN(q0 + 3)) { PFRAME_L(); KArgs A = kargs(); moe_combine_phase(P, A, l); }
        SEAM(q0 + 3);
    }
#undef IN
#undef SEAM
}

extern "C" void kernel_launch(void* const* d_in, const int* in_sizes, int n_in, void* d_out, int out_size, void* d_ws, size_t ws_size, hipStream_t stream) {
    static int grid = 0;
    if (grid == 0) {
        if (n_in != 30 || in_sizes[0] != NTOK * DM || out_size != NTOK * DM || ws_size < WS_END) {
            fprintf(stderr, "kernel_launch: unexpected problem: n_in %d in0 %d out %d ws %zu (need %zu)\n", n_in, n_in > 0 ? in_sizes[0] : -1, out_size, ws_size, (size_t)WS_END); grid = -1; return; }
        int dev = 0, cus = 0, per_cu = 0;
        if (hipGetDevice(&dev) != hipSuccess || hipDeviceGetAttribute(&cus, hipDeviceAttributeMultiprocessorCount, dev) != hipSuccess) { grid = -1; return; }
        if (hipFuncSetAttribute((const void*)mk_fwd, hipFuncAttributeMaxDynamicSharedMemorySize, LDS_BYTES) != hipSuccess) { fprintf(stderr, "kernel_launch: hipFuncSetAttribute failed\n"); grid = -1; return; }
        if (hipOccupancyMaxActiveBlocksPerMultiprocessor(&per_cu, (const void*)mk_fwd, NWAVES * 64, LDS_BYTES) != hipSuccess || per_cu < 1)
            fprintf(stderr, "kernel_launch: note: occupancy query reports %d workgroups per CU\n", per_cu);
        (void)hipGetLastError();
        grid = cus;
    }
    if (grid < 0) return;
    if (hipMemsetAsync((char*)d_ws + WS_CTL, 0, CTL_ZERO_BYTES, stream) != hipSuccess) return;
    Args a{};
    for (int i = 0; i < 30; ++i) a.in[i] = (const float*)d_in[i];
    a.out = (float*)d_out; a.ws = (unsigned char*)d_ws;
#if MK_ONE_LAUNCH
    a.ph_lo = 0; a.ph_hi = N_PHASES;
    hipLaunchKernelGGL(mk_fwd, dim3(grid), dim3(NWAVES * 64), LDS_BYTES, stream, a);
#else
#ifndef MK_LAST
#define MK_LAST N_PHASES
#endif
    for (int k = 0; k < MK_LAST; ++k) { a.ph_lo = k; a.ph_hi = k + 1; hipLaunchKernelGGL(mk_fwd, dim3(grid), dim3(NWAVES * 64), LDS_BYTES, stream, a); }
#endif
}
```
